# Optimizing an MI355X kernel written in HIP

```python
import math
import jax, jax.numpy as jnp
from jax import lax
import numpy as np

D_MODEL = 1024
BATCH = 8
SEQ = 4096
DEPTH = 4

S5_WIDTH = 256
S5_GROUP = 16
S5_GROUPS = S5_WIDTH // S5_GROUP
S5_STATE = 64
S5_DT_MIN = 0.001
S5_DT_MAX = 0.1

DSA_HEADS = 8
DSA_HEAD_DIM = 64
DSA_WIDTH = DSA_HEADS * DSA_HEAD_DIM
DSA_KV_DIM = 64
IDX_HEADS = 4
IDX_DIM = 64
DSA_TOPK_MAX = 256
Q_BLOCK = 128

RET_HEADS = 4
RET_HEAD_DIM = 64
RET_WIDTH = RET_HEADS * RET_HEAD_DIM
RET_CHUNK = 128
ROPE_BASE = 10000.0

REL_BUCKETS = 32
REL_MAX_DIST = 128

D_FF = ((8 * D_MODEL // 3 + 255) // 256) * 256
MIX_WIDTH = S5_WIDTH + DSA_WIDTH + RET_WIDTH

IN_SPLITS = (S5_WIDTH,
             DSA_WIDTH, DSA_KV_DIM, DSA_KV_DIM,
             IDX_HEADS * IDX_DIM, IDX_DIM, IDX_HEADS,
             RET_WIDTH, RET_WIDTH, RET_WIDTH, RET_WIDTH)
IN_WIDTH = sum(IN_SPLITS)

RMS_EPS = 1e-6
GN_EPS = 1e-6
NEG_INF = -1e30

kernel_name = "hybrid_s5_dsa_retention_trunk"


def rmsnorm(x, g):
    xf = x.astype(jnp.float32)
    y = xf * lax.rsqrt(jnp.mean(xf * xf, axis=-1, keepdims=True) + RMS_EPS)
    return (y * g.astype(jnp.float32)).astype(x.dtype)


def t5_bucket(dist):
    n = jnp.maximum(dist, 0)
    max_exact = REL_BUCKETS // 2
    nf = jnp.maximum(n, 1).astype(jnp.float32)
    large = max_exact + (jnp.log(nf / max_exact) / math.log(REL_MAX_DIST / max_exact)
                         * (REL_BUCKETS - max_exact)).astype(jnp.int32)
    large = jnp.minimum(large, REL_BUCKETS - 1)
    return jnp.where(n < max_exact, n, large)


def rotary(x, pos):
    half = x.shape[-1] // 2
    inv = ROPE_BASE ** (-jnp.arange(half, dtype=jnp.float32) / half)
    ang = pos.astype(jnp.float32)[:, None] * inv[None, :]
    cos = jnp.cos(ang)[None, :, None, :]
    sin = jnp.sin(ang)[None, :, None, :]
    x1, x2 = x[..., :half], x[..., half:]
    return jnp.concatenate([x1 * cos - x2 * sin, x2 * cos + x1 * sin], axis=-1)


def s5_mixer(u, a_re, a_im, log_dt, b_re, b_im, c_re, c_im, d_skip, glu_w, glu_b):
    bsz, seq, _ = u.shape
    f32 = jnp.float32
    uf = u.astype(f32).reshape(bsz, seq, S5_GROUPS, S5_GROUP)
    ar, ai = a_re.astype(f32), a_im.astype(f32)
    dt = jnp.exp(log_dt.astype(f32))[:, None]
    mag = jnp.exp(ar * dt)
    ang = ai * dt
    abr, abi = mag * jnp.cos(ang), mag * jnp.sin(ang)
    den = ar * ar + ai * ai
    nr, ni = abr - 1.0, abi
    cr = (nr * ar + ni * ai) / den
    ci = (ni * ar - nr * ai) / den
    br, bi = b_re.astype(f32), b_im.astype(f32)
    bbr = cr[..., None] * br - ci[..., None] * bi
    bbi = cr[..., None] * bi + ci[..., None] * br
    xr = jnp.einsum('blgp,gnp->blgn', uf, bbr)
    xi = jnp.einsum('blgp,gnp->blgn', uf, bbi)
    a_r = jnp.broadcast_to(abr, (1, seq, S5_GROUPS, S5_STATE))
    a_i = jnp.broadcast_to(abi, (1, seq, S5_GROUPS, S5_STATE))

    def combine(e1, e2):
        a1r, a1i, b1r, b1i = e1
        a2r, a2i, b2r, b2i = e2
        return (a2r * a1r - a2i * a1i,
                a2r * a1i + a2i * a1r,
                a2r * b1r - a2i * b1i + b2r,
                a2r * b1i + a2i * b1r + b2i)

    _, _, hr, hi = lax.associative_scan(combine, (a_r, a_i, xr, xi), axis=1)
    y = (jnp.einsum('blgn,gpn->blgp', hr, c_re.astype(f32))
         - jnp.einsum('blgn,gpn->blgp', hi, c_im.astype(f32))
         + d_skip.astype(f32)[None, None] * uf)
    y = jax.nn.gelu(y.reshape(bsz, seq, S5_WIDTH))
    y = y * jax.nn.sigmoid(y @ glu_w.astype(f32) + glu_b.astype(f32))
    return y.astype(u.dtype)


def dsa_attention(q, k, v, q_idx, k_idx, w_idx, rel_bias):
    f32 = jnp.float32
    bsz, seq = q.shape[0], q.shape[1]
    k_sel = min(DSA_TOPK_MAX, seq // 4)
    n_blk = seq // Q_BLOCK

    def to_blocks(a):
        return jnp.swapaxes(a.reshape((bsz, n_blk, Q_BLOCK) + a.shape[2:]), 0, 1)

    kidx = k_idx.astype(f32)
    key_pos = jnp.arange(seq, dtype=jnp.int32)
    scale = DSA_HEAD_DIM ** -0.5

    def block(args):
        qb, qib, wb, start = args
        q_pos = start + jnp.arange(Q_BLOCK, dtype=jnp.int32)
        dots = jnp.einsum('bqhd,bsd->bqhs', qib.astype(f32), kidx) * (IDX_DIM ** -0.5)
        score = jnp.einsum('bqhs,bqh->bqs', jax.nn.relu(dots), wb.astype(f32)) * (IDX_HEADS ** -0.5)
        causal = key_pos[None, None, :] <= q_pos[None, :, None]
        score = jnp.where(causal, score, NEG_INF)
        _, sel = lax.top_k(score, k_sel)
        flat = sel.reshape(bsz, Q_BLOCK * k_sel, 1)
        kg = jnp.take_along_axis(k, flat, axis=1).reshape(bsz, Q_BLOCK, k_sel, DSA_KV_DIM)
        vg = jnp.take_along_axis(v, flat, axis=1).reshape(bsz, Q_BLOCK, k_sel, DSA_KV_DIM)
        dist = q_pos[None, :, None] - sel
        bias = jnp.moveaxis(rel_bias[t5_bucket(dist)], -1, 2)
        logits = (jnp.einsum('bqhd,bqkd->bqhk', qb, kg).astype(f32) * scale
                  + bias.astype(f32))
        logits = jnp.where((dist >= 0)[:, :, None, :], logits, NEG_INF)
        p = jax.nn.softmax(logits, axis=-1).astype(v.dtype)
        return jnp.einsum('bqhk,bqkd->bqhd', p, vg)

    starts = jnp.arange(n_blk, dtype=jnp.int32) * Q_BLOCK
    out = lax.map(block, (to_blocks(q), to_blocks(q_idx), to_blocks(w_idx), starts))
    return jnp.swapaxes(out, 0, 1).reshape(bsz, seq, DSA_WIDTH)


def retention(q, k, v, g, gn_w):
    f32 = jnp.float32
    bsz, seq, _ = q.shape
    nc = seq // RET_CHUNK
    pos = jnp.arange(seq, dtype=jnp.int32)
    shp = (bsz, seq, RET_HEADS, RET_HEAD_DIM)
    qf = rotary(q.astype(f32).reshape(shp), pos)
    kf = rotary(k.astype(f32).reshape(shp), pos) * (RET_HEAD_DIM ** -0.5)
    vf = v.astype(f32).reshape(shp)
    cshp = (bsz, nc, RET_CHUNK, RET_HEADS, RET_HEAD_DIM)
    qc, kc, vc = qf.reshape(cshp), kf.reshape(cshp), vf.reshape(cshp)

    gamma = 1.0 - 2.0 ** (-5.0 - jnp.arange(RET_HEADS, dtype=f32))
    log_g = jnp.log(gamma)
    i = jnp.arange(RET_CHUNK, dtype=f32)
    diff = i[:, None] - i[None, :]
    decay = jnp.where(diff >= 0, jnp.exp(log_g[:, None, None] * jnp.maximum(diff, 0.0)), 0.0)

    qk = jnp.einsum('bnihd,bnjhd->bnhij', qc, kc) * decay[None, None]
    inner = jnp.einsum('bnhij,bnjhd->bnihd', qk, vc)

    wk = jnp.exp(log_g[:, None] * (RET_CHUNK - 1.0 - i)[None, :])
    kv = jnp.einsum('bnjhd,hj,bnjhe->bnhde', kc, wk, vc)
    g_chunk = jnp.exp(log_g * RET_CHUNK)[None, :, None, None]

    def step(state, kv_n):
        return g_chunk * state + kv_n, state

    init = jnp.zeros((bsz, RET_HEADS, RET_HEAD_DIM, RET_HEAD_DIM), f32)
    _, prev = lax.scan(step, init, jnp.swapaxes(kv, 0, 1))
    prev = jnp.swapaxes(prev, 0, 1)
    wq = jnp.exp(log_g[:, None] * (i + 1.0)[None, :])
    cross = jnp.einsum('bnihd,bnhde->bnihe', qc, prev) * wq.T[None, None, :, :, None]
    o = (inner + cross).reshape(shp)

    mu = jnp.mean(o, axis=-1, keepdims=True)
    var = jnp.mean(jnp.square(o - mu), axis=-1, keepdims=True)
    o = ((o - mu) * lax.rsqrt(var + GN_EPS)).reshape(bsz, seq, RET_WIDTH) * gn_w.astype(f32)
    return (jax.nn.silu(g.astype(f32)) * o).astype(q.dtype)


def setup_inputs(seed: int = 0) -> dict:
    key = jax.random.key(seed)
    ks = jax.random.split(key, 24)
    f32 = jnp.float32
    nrm = lambda k, s: jax.random.normal(k, s, f32)
    G, N, P = S5_GROUPS, S5_STATE, S5_GROUP
    lo, hi = math.log(S5_DT_MIN), math.log(S5_DT_MAX)
    return {
        "x": nrm(ks[0], (BATCH, SEQ, D_MODEL)),
        "w_in": nrm(ks[1], (DEPTH, D_MODEL, IN_WIDTH)) * D_MODEL ** -0.5,
        "w_out": nrm(ks[2], (DEPTH, MIX_WIDTH, D_MODEL)) * MIX_WIDTH ** -0.5,
        "norm_mix": 1.0 + 0.02 * nrm(ks[3], (DEPTH, D_MODEL)),
        "ssm_a_re": -0.5 + 0.01 * nrm(ks[4], (DEPTH, G, N)),
        "ssm_a_im": math.pi * jnp.arange(N, dtype=f32)[None, None, :] + 0.01 * nrm(ks[5], (DEPTH, G, N)),
        "ssm_log_dt": lo + (hi - lo) * jax.random.uniform(ks[6], (DEPTH, G), f32),
        "ssm_b_re": nrm(ks[7], (DEPTH, G, N, P)) * (2.0 * P) ** -0.5,
        "ssm_b_im": nrm(ks[8], (DEPTH, G, N, P)) * (2.0 * P) ** -0.5,
        "ssm_c_re": nrm(ks[9], (DEPTH, G, P, N)) * (2.0 * N) ** -0.5,
        "ssm_c_im": nrm(ks[10], (DEPTH, G, P, N)) * (2.0 * N) ** -0.5,
        "ssm_d": nrm(ks[11], (DEPTH, G, P)),
        "ssm_glu_w": nrm(ks[12], (DEPTH, S5_WIDTH, S5_WIDTH)) * S5_WIDTH ** -0.5,
        "ssm_glu_b": 0.01 * nrm(ks[13], (DEPTH, S5_WIDTH)),
        "rel_bias": 0.5 * nrm(ks[14], (REL_BUCKETS, DSA_HEADS)),
        "ret_gn": 1.0 + 0.02 * nrm(ks[15], (DEPTH, RET_WIDTH)),
        "norm_ffn": 1.0 + 0.02 * nrm(ks[16], (DEPTH, D_MODEL)),
        "w_ffn_in": nrm(ks[17], (DEPTH, D_MODEL, 2 * D_FF)) * D_MODEL ** -0.5,
        "w_ffn_out": nrm(ks[18], (DEPTH, D_FF, D_MODEL)) * D_FF ** -0.5,
        "norm_final": 1.0 + 0.02 * nrm(ks[19], (D_MODEL,)),
    }


def reference(x, w_in, w_out, norm_mix, ssm_a_re, ssm_a_im, ssm_log_dt, ssm_b_re, ssm_b_im,
              ssm_c_re, ssm_c_im, ssm_d, ssm_glu_w, ssm_glu_b, rel_bias, ret_gn,
              norm_ffn, w_ffn_in, w_ffn_out, norm_final):
    bsz, seq, _ = x.shape
    split_pts = [int(s) for s in np.cumsum(IN_SPLITS)[:-1]]
    for l in range(DEPTH):
        h = rmsnorm(x, norm_mix[l])
        proj = h @ w_in[l]
        (u, dq, dk, dv, iq, ik, iw, rq, rk, rv, rg) = jnp.split(proj, split_pts, axis=-1)
        y_a = s5_mixer(u, ssm_a_re[l], ssm_a_im[l], ssm_log_dt[l], ssm_b_re[l], ssm_b_im[l],
                       ssm_c_re[l], ssm_c_im[l], ssm_d[l], ssm_glu_w[l], ssm_glu_b[l])
        y_b = dsa_attention(dq.reshape(bsz, seq, DSA_HEADS, DSA_HEAD_DIM), dk, dv,
                            iq.reshape(bsz, seq, IDX_HEADS, IDX_DIM), ik, iw, rel_bias)
        y_c = retention(rq, rk, rv, rg, ret_gn[l])
        mix = jnp.concatenate([y_a, y_b.astype(x.dtype), y_c], axis=-1)
        x = x + mix @ w_out[l]
        h = rmsnorm(x, norm_ffn[l])
        gate, up = jnp.split(h @ w_ffn_in[l], 2, axis=-1)
        x = x + (jax.nn.silu(gate) * up) @ w_ffn_out[l]
    return rmsnorm(x, norm_final)
```

```cpp
#include <hip/hip_runtime.h>
#include <cstdio>
#include <cstdint>

constexpr int D_MODEL = 1024, BATCH = 8, SEQ = 4096, DEPTH = 4, MTOK = BATCH * SEQ;
constexpr int S5_G = 16, S5_P = 16, S5_N = 64;
constexpr int DSA_H = 8, IDX_H = 4, TOPK = 256;
constexpr int RET_H = 4;
constexpr int D_FF = 2816, IN_W = 2244, NPROJ = 2304;
constexpr int PC_U = 0, PC_DQ = 256, PC_DK = 768, PC_DV = 832, PC_IK = 896, PC_IW = 960, PC_IQ = 1024, PC_RQ = 1280, PC_RK = 1536, PC_RV = 1792, PC_RG = 2048;
constexpr float RMS_EPS = 1e-6f, GN_EPS = 1e-6f;

constexpr size_t MiB = 1u << 20;
constexpr size_t WS_CTL = 0, CTL_ZERO_BYTES = 1 * MiB;
constexpr size_t WS_WIN = 2 * MiB;
constexpr size_t WS_WOUT = 20 * MiB;
constexpr size_t WS_WFFI = 28 * MiB;
constexpr size_t WS_WFFO = 72 * MiB;
constexpr size_t WS_TAB = 94 * MiB;
constexpr size_t WS_XB = 106 * MiB;
constexpr size_t WS_SS = 170 * MiB;
constexpr size_t WS_PROJ = 172 * MiB;
constexpr size_t WS_MIX = 316 * MiB;
constexpr size_t WS_HID = 172 * MiB;
constexpr size_t WS_S5M = 380 * MiB;
constexpr size_t WS_S5W = 416 * MiB;
constexpr size_t WS_S5U = 424 * MiB;
constexpr size_t WS_S5E = 442 * MiB;
constexpr size_t WS_YG = 474 * MiB;
constexpr size_t WS_GLUT = 490 * MiB;
constexpr size_t WS_KVI = 492 * MiB;
constexpr size_t WS_END = 508 * MiB;
constexpr size_t TB_ROPE = 0;
constexpr size_t TB_LUT = 1 * MiB;
constexpr size_t TB_S5AB = 1 * MiB + 65536;
constexpr size_t TB_S5BB = TB_S5AB + 65536;
constexpr size_t TB_S5C = TB_S5BB + 524288;
constexpr size_t TB_POW = 3 * MiB;
constexpr size_t TB_KC = 6 * MiB;
constexpr int S5K = 1152;
constexpr size_t S5_KR_ELEMS = (size_t)16 * 16 * 128 * 16;
constexpr int KV_LD = 256, KV_DK = 0, KV_DV = 64, KV_IK = 128, KV_IW = 192;
constexpr int CW_BAR = 4096;
constexpr int CW_WORK = 16384;

constexpr int RING_BYTES = 131072;
constexpr int LDS_BYTES = 147456;
constexpr int MISC_OFF = LDS_BYTES - 256;
constexpr int NWAVES = 8;

#define GAS __attribute__((address_space(1)))
#define LAS __attribute__((address_space(3)))
typedef unsigned short bf16_t;
typedef short bf16x8 __attribute__((ext_vector_type(8)));
typedef float f32x4 __attribute__((ext_vector_type(4)));
typedef unsigned u32x4 __attribute__((ext_vector_type(4)));
typedef unsigned u32x2 __attribute__((ext_vector_type(2)));

__device__ __forceinline__ unsigned f2bf(float f) { unsigned u = __builtin_bit_cast(unsigned, f); return (u + 0x7fffu + ((u >> 16) & 1u)) >> 16; }
__device__ __forceinline__ unsigned pk2(float lo, float hi) { return f2bf(lo) | (f2bf(hi) << 16); }
__device__ __forceinline__ float bflo(unsigned w) { return __builtin_bit_cast(float, w << 16); }
__device__ __forceinline__ float bfhi(unsigned w) { return __builtin_bit_cast(float, w & 0xffff0000u); }
__device__ __forceinline__ unsigned pk4_f8(float a, float b, float c, float d) {
    a = __builtin_amdgcn_fmed3f(a, -448.f, 448.f); b = __builtin_amdgcn_fmed3f(b, -448.f, 448.f); c = __builtin_amdgcn_fmed3f(c, -448.f, 448.f); d = __builtin_amdgcn_fmed3f(d, -448.f, 448.f);
    int w = __builtin_amdgcn_cvt_pk_fp8_f32(a, b, 0, false); w = __builtin_amdgcn_cvt_pk_fp8_f32(c, d, w, true); return (unsigned)w; }
constexpr float F8_WS = 64.0f, F8_HS = 8.0f;
__device__ __forceinline__ float bf1(bf16_t h) { return __builtin_bit_cast(float, ((unsigned)h) << 16); }
#define LDS_WAIT() asm volatile("s_waitcnt lgkmcnt(0)" ::: "memory")
#define VM_WAIT() asm volatile("s_waitcnt vmcnt(0)" ::: "memory")
__device__ __forceinline__ int lane_id() { int z = 0; asm volatile("" : "+v"(z)); return (int)__builtin_amdgcn_mbcnt_hi(~0u, __builtin_amdgcn_mbcnt_lo(~0u, (unsigned)z)); }

typedef unsigned u32x2v __attribute__((ext_vector_type(2)));
__device__ __forceinline__ u32x2v plswap16(float v) { unsigned a = __builtin_bit_cast(unsigned, v), b = a; asm volatile("" : "+v"(b)); return __builtin_amdgcn_permlane16_swap(a, b, false, false); }
__device__ __forceinline__ u32x2v plswap32(float v) { unsigned a = __builtin_bit_cast(unsigned, v), b = a; asm volatile("" : "+v"(b)); return __builtin_amdgcn_permlane32_swap(a, b, false, false); }
__device__ __forceinline__ float x16_sum(float v) { const u32x2v r = plswap16(v); const unsigned r0 = r[0], r1 = r[1]; return __uint_as_float(r0) + __uint_as_float(r1); }
__device__ __forceinline__ float x32_sum(float v) { const u32x2v r = plswap32(v); const unsigned r0 = r[0], r1 = r[1]; return __uint_as_float(r0) + __uint_as_float(r1); }
__device__ __forceinline__ float x16_max(float v) { const u32x2v r = plswap16(v); const unsigned r0 = r[0], r1 = r[1]; return fmaxf(__uint_as_float(r0), __uint_as_float(r1)); }
__device__ __forceinline__ float x32_max(float v) { const u32x2v r = plswap32(v); const unsigned r0 = r[0], r1 = r[1]; return fmaxf(__uint_as_float(r0), __uint_as_float(r1)); }
__device__ __forceinline__ float xq_sum(float v) { return x32_sum(x16_sum(v)); }
__device__ __forceinline__ float xq_max(float v) { return x32_max(x16_max(v)); }
template <int CTRL> __device__ __forceinline__ float dpp_f(float v) { return __builtin_bit_cast(float, __builtin_amdgcn_update_dpp(0, __builtin_bit_cast(int, v), CTRL, 0xf, 0xf, true)); }
__device__ __forceinline__ float row_sum(float v) { v += dpp_f<0xB1>(v); v += dpp_f<0x4E>(v); v += dpp_f<0x141>(v); v += dpp_f<0x140>(v); return v; }
__device__ __forceinline__ float row_max(float v) { v = fmaxf(v, dpp_f<0xB1>(v)); v = fmaxf(v, dpp_f<0x4E>(v)); v = fmaxf(v, dpp_f<0x141>(v)); v = fmaxf(v, dpp_f<0x140>(v)); return v; }
__device__ __forceinline__ int bperm_i(int v, int src_lane) { return __builtin_amdgcn_ds_bpermute(src_lane << 2, v); }
__device__ __forceinline__ float bperm_f(float v, int src_lane) { return __builtin_bit_cast(float, __builtin_amdgcn_ds_bpermute(src_lane << 2, __builtin_bit_cast(int, v))); }

namespace pg8 {
#define PG8_LAS __attribute__((address_space(3)))
constexpr int BM = 256, BK = 64, HALF = 128, HTB = HALF * BK * 2, STAGE_BYTES = 8 * HTB, NXCD = 8, WGM = 8;
__host__ __device__ __forceinline__ int lds_byte(int r, int c) { const int st = (r >> 4) * 2 + (c >> 5), rr = r & 15, cc = c & 31, ob = rr * 64 + cc * 2; return st * 1024 + (ob ^ (((ob >> 9) & 1) << 5)); }
__host__ __device__ __forceinline__ void stage_rc(int b, int& R, int& C) { const int st = b / 1024, sb = b % 1024, swz = sb ^ (((sb >> 9) & 1) << 5); R = (st >> 1) * 16 + swz / 64; C = (st & 1) * 32 + (swz % 64) / 2; }
__host__ __device__ __forceinline__ int perm32(int rho) { const int n = rho >> 4, i = rho & 15; return 8 * (i >> 2) + 4 * n + (i & 3); }

typedef int i32x8v __attribute__((ext_vector_type(8)));
typedef int i32x4v __attribute__((ext_vector_type(4)));
struct Unit { int pm, pn; };
struct Gemm { const bf16_t* A; const bf16_t* Bt; int lda, ldb, K; const bf16_t* B2 = nullptr; };

struct StaticOrder {
    int nM, nN, nwg, G, c;
    __host__ __device__ __forceinline__ void init(int M, int N, int G_, int c_) { nM = M / BM; nN = N / BM; nwg = nM * nN; G = G_; c = c_; }
    __host__ __device__ __forceinline__ bool next(int i, Unit& u) const {
        const long L = (long)i * G + c; if (L >= nwg) return false;
        int wgid = (int)L; { const int q = nwg / NXCD, r = nwg % NXCD, xcd = wgid % NXCD, off = wgid / NXCD; wgid = (xcd < r ? xcd * (q + 1) : r * (q + 1) + (xcd - r) * q) + off; }
        const int nig = WGM * nN, gid = wgid / nig, fm = gid * WGM, gsz = (nM - fm) < WGM ? (nM - fm) : WGM;
        u.pm = fm + ((wgid % nig) % gsz); u.pn = (wgid % nig) / gsz; return true;
    }
    __device__ __forceinline__ void a_ready(const Unit&) const {}
    __device__ __forceinline__ void done(const Unit&) const {}
};

__device__ __forceinline__ unsigned cvt_pk_bf16(float lo, float hi) { unsigned r; asm volatile("v_cvt_pk_bf16_f32 %0, %1, %2" : "=v"(r) : "v"(lo), "v"(hi)); return r; }

__device__ __forceinline__ float row_rstd(const float* ss, int row) {
    const f32x4* sp = (const f32x4*)(ss + (size_t)row * 16);
    const f32x4 a = sp[0], b = sp[1], c = sp[2], d = sp[3];
    const float s = ((a[0] + a[1]) + (a[2] + a[3])) + ((b[0] + b[1]) + (b[2] + b[3])) + ((c[0] + c[1]) + (c[2] + c[3])) + ((d[0] + d[1]) + (d[2] + d[3]));
    return 1.0f / sqrtf(s * (1.0f / D_MODEL) + RMS_EPS);
}
struct EpiProj {
    static constexpr bool PERM = true, AFTER_DRAIN = false;
    bf16_t* O; int ldc; const PG8_LAS float* rs_tab; bf16_t* U; bf16_t* KVI;
    __device__ __forceinline__ void operator()(const f32x4 (&acc)[2][2][4][2], const Unit& u, int wr, int wc, int fr, int fq, int ui) const {
        const int row0 = u.pm * BM + wr * 64 + fr, col0 = u.pn * BM + wc * 32 + 8 * fq;
#pragma unroll
        for (int ai = 0; ai < 2; ++ai)
#pragma unroll
            for (int m = 0; m < 4; ++m) { const int row = row0 + ai * HALF + m * 16; const float rs = rs_tab[ui * 256 + (row - u.pm * BM)]; bf16_t* rowp = O + (size_t)row * ldc + col0;
#pragma unroll
                for (int bj = 0; bj < 2; ++bj) { const f32x4 v0 = acc[ai][bj][m][0] * rs, v1 = acc[ai][bj][m][1] * rs;
                    u32x4 w; w.x = cvt_pk_bf16(v0[0], v0[1]); w.y = cvt_pk_bf16(v0[2], v0[3]); w.z = cvt_pk_bf16(v1[0], v1[1]); w.w = cvt_pk_bf16(v1[2], v1[3]);
                    if (u.pn == 0) { const int ch = col0 + bj * HALF; *(u32x4*)(U + ((size_t)(ch >> 4) * 512 + (row >> 6)) * S5K + (row & 63) * 16 + (ch & 15)) = w; }
                    else if (u.pn == 3) *(u32x4*)(KVI + (size_t)row * KV_LD + (col0 - 3 * BM) + bj * HALF) = w;
                    else *(u32x4*)(rowp + bj * HALF) = w; } }
    }
};
struct EpiS5State {
    static constexpr bool PERM = false, AFTER_DRAIN = false;
    float* E;
    __device__ __forceinline__ void operator()(const f32x4 (&acc)[2][2][4][2], const Unit&, int wr, int wc, int fr, int fq, int ui) const {
#pragma unroll
        for (int ai = 0; ai < 2; ++ai)
#pragma unroll
            for (int m = 0; m < 4; ++m) { const int r = ai * HALF + wr * 64 + m * 16 + fr;
#pragma unroll
                for (int n = 0; n < 2; ++n) *(f32x4*)(E + (size_t)r * 128 + wc * 32 + 16 * n + 4 * fq) = acc[ai][0][m][n]; }
    }
};
__device__ __forceinline__ float gelu_tanh_f(float y) {
    const float t = 0.7978845608028654f * (y + 0.044715f * y * y * y);
    const float e = __expf(2.0f * t);
    return y * (1.0f - __builtin_amdgcn_rcpf(e + 1.0f));
}
struct EpiS5Y {
    static constexpr bool PERM = true, AFTER_DRAIN = false;
    bf16_t* YG; int g;
    __device__ __forceinline__ void operator()(const f32x4 (&acc)[2][2][4][2], const Unit& u, int wr, int wc, int fr, int fq, int ui) const {
        const int row0 = u.pm * BM + wr * 64 + fr, col0 = u.pn * BM + wc * 32 + 8 * fq;
#pragma unroll
        for (int ai = 0; ai < 2; ++ai)
#pragma unroll
            for (int m = 0; m < 4; ++m) { const int row = row0 + ai * HALF + m * 16;
#pragma unroll
                for (int bj = 0; bj < 2; ++bj) { const int c = col0 + bj * HALF; const f32x4 a0 = acc[ai][bj][m][0], a1 = acc[ai][bj][m][1];
                    u32x4 w; w.x = cvt_pk_bf16(gelu_tanh_f(a0[0]), gelu_tanh_f(a0[1])); w.y = cvt_pk_bf16(gelu_tanh_f(a0[2]), gelu_tanh_f(a0[3]));
                    w.z = cvt_pk_bf16(gelu_tanh_f(a1[0]), gelu_tanh_f(a1[1])); w.w = cvt_pk_bf16(gelu_tanh_f(a1[2]), gelu_tanh_f(a1[3]));
                    *(u32x4*)(YG + ((size_t)row * 64 + (c >> 4)) * 256 + 16 * g + (c & 15)) = w; } }
    }
};
struct EpiGLU {
    static constexpr bool PERM = true, AFTER_DRAIN = false;
    const bf16_t* YG; bf16_t* MIX; const float* bias;
    __device__ __forceinline__ void operator()(const f32x4 (&acc)[2][2][4][2], const Unit& u, int wr, int wc, int fr, int fq, int ui) const {
        const int row0 = u.pm * BM + wr * 64 + fr, col0 = wc * 32 + 8 * fq;
#pragma unroll
        for (int ai = 0; ai < 2; ++ai)
#pragma unroll
            for (int m = 0; m < 4; ++m) { const int row = row0 + ai * HALF + m * 16;
#pragma unroll
                for (int bj = 0; bj < 2; ++bj) { const int c = col0 + bj * HALF;
                    const u32x4 yv = *(const u32x4*)(YG + (size_t)row * 256 + c);
                    const f32x4 b0 = *(const f32x4*)(bias + c), b1 = *(const f32x4*)(bias + c + 4);
                    const f32x4 z0 = acc[ai][bj][m][0] + b0, z1 = acc[ai][bj][m][1] + b1;
                    const float y[8] = {bflo(yv.x), bfhi(yv.x), bflo(yv.y), bfhi(yv.y), bflo(yv.z), bfhi(yv.z), bflo(yv.w), bfhi(yv.w)};
                    float o[8];
#pragma unroll
                    for (int j = 0; j < 4; ++j) { o[j] = y[j] * __builtin_amdgcn_rcpf(1.0f + __expf(-z0[j])); o[4 + j] = y[4 + j] * __builtin_amdgcn_rcpf(1.0f + __expf(-z1[j])); }
                    u32x4 w; w.x = cvt_pk_bf16(o[0], o[1]); w.y = cvt_pk_bf16(o[2], o[3]); w.z = cvt_pk_bf16(o[4], o[5]); w.w = cvt_pk_bf16(o[6], o[7]);
                    *(u32x4*)(MIX + (size_t)row * 1024 + c) = w; } }
    }
};
struct RowUnits {
    int pm, n;
    __device__ __forceinline__ bool next(int i, Unit& u) const { if (i >= n) return false; u.pm = pm; u.pn = i; return true; }
    __device__ __forceinline__ void a_ready(const Unit&) const {}
    __device__ __forceinline__ void done(const Unit&) const {}
};
struct SingleUnit {
    int pm, pn;
    __device__ __forceinline__ bool next(int i, Unit& u) const { if (i != 0) return false; u.pm = pm; u.pn = pn; return true; }
    __device__ __forceinline__ void a_ready(const Unit&) const {}
    __device__ __forceinline__ void done(const Unit&) const {}
};
struct EpiSwiGLU {
    static constexpr bool PERM = true, AFTER_DRAIN = false;
    bf16_t* O; int ldc; const PG8_LAS float* rs_tab;
    __device__ __forceinline__ void operator()(const f32x4 (&acc)[2][2][4][2], const Unit& u, int wr, int wc, int fr, int fq, int ui) const {
        const int row0 = u.pm * BM + wr * 64 + fr, col0 = u.pn * HALF + wc * 32 + 8 * fq;
#pragma unroll
        for (int ai = 0; ai < 2; ++ai)
#pragma unroll
            for (int m = 0; m < 4; ++m) { const int row = row0 + ai * HALF + m * 16; const float rs = rs_tab[ui * 256 + (row - u.pm * BM)];
                float h[8];
#pragma unroll
                for (int n = 0; n < 2; ++n)
#pragma unroll
                    for (int j = 0; j < 4; ++j) { const float g = acc[ai][0][m][n][j] * rs, up = acc[ai][1][m][n][j] * rs; h[n * 4 + j] = g * __builtin_amdgcn_rcpf(1.0f + __expf(-g)) * up; }
                u32x4 w; w.x = cvt_pk_bf16(h[0], h[1]); w.y = cvt_pk_bf16(h[2], h[3]); w.z = cvt_pk_bf16(h[4], h[5]); w.w = cvt_pk_bf16(h[6], h[7]);
                *(u32x4*)(O + (size_t)row * ldc + col0) = w; }
    }
};
struct EpiSwiGLU8 {
    static constexpr bool PERM = true, AFTER_DRAIN = false;
    unsigned char* O; int ldc; const PG8_LAS float* rs_tab;
    __device__ __forceinline__ void operator()(const f32x4 (&acc)[2][2][4][2], const Unit& u, int wr, int wc, int fr, int fq, int ui) const {
        const int row0 = u.pm * BM + wr * 64 + fr, col0 = u.pn * HALF + wc * 32 + 8 * fq;
#pragma unroll
        for (int ai = 0; ai < 2; ++ai)
#pragma unroll
            for (int m = 0; m < 4; ++m) { const int row = row0 + ai * HALF + m * 16; const float rs = rs_tab[ui * 256 + (row - u.pm * BM)];
                float h[8];
#pragma unroll
                for (int n = 0; n < 2; ++n)
#pragma unroll
                    for (int j = 0; j < 4; ++j) { const float g = acc[ai][0][m][n][j] * rs, up = acc[ai][1][m][n][j] * rs; h[n * 4 + j] = g * __builtin_amdgcn_rcpf(1.0f + __expf(-g)) * up * F8_HS; }
                u32x2 w; w.x = pk4_f8(h[0], h[1], h[2], h[3]); w.y = pk4_f8(h[4], h[5], h[6], h[7]);
                *(u32x2*)(O + (size_t)row * ldc + col0) = w; }
    }
};
struct EpiResid {
    static constexpr bool PERM = true, AFTER_DRAIN = false;
    const float* xin; float* xout; bf16_t* xb; float* ss;
    __device__ __forceinline__ void operator()(const f32x4 (&acc)[2][2][4][2], const Unit& u, int wr, int wc, int fr, int fq, int ui) const {
        const int row0 = u.pm * BM + wr * 64 + fr, col0 = u.pn * BM + wc * 32 + 8 * fq;
#pragma unroll
        for (int ai = 0; ai < 2; ++ai) {
            f32x4 xv[4][2][2];
#pragma unroll
            for (int m = 0; m < 4; ++m)
#pragma unroll
                for (int bj = 0; bj < 2; ++bj) { const size_t off = (size_t)(row0 + ai * HALF + m * 16) * D_MODEL + col0 + bj * HALF;
                    xv[m][bj][0] = *(const f32x4*)(xin + off); xv[m][bj][1] = *(const f32x4*)(xin + off + 4); }
            __builtin_amdgcn_sched_barrier(0);
#pragma unroll
            for (int m = 0; m < 4; ++m) { const int row = row0 + ai * HALF + m * 16; float sq = 0.f;
#pragma unroll
                for (int bj = 0; bj < 2; ++bj) { const size_t off = (size_t)row * D_MODEL + col0 + bj * HALF;
                    const f32x4 x0 = xv[m][bj][0] + acc[ai][bj][m][0], x1 = xv[m][bj][1] + acc[ai][bj][m][1];
                    *(f32x4*)(xout + off) = x0; *(f32x4*)(xout + off + 4) = x1;
                    u32x4 w; w.x = cvt_pk_bf16(x0[0], x0[1]); w.y = cvt_pk_bf16(x0[2], x0[3]); w.z = cvt_pk_bf16(x1[0], x1[1]); w.w = cvt_pk_bf16(x1[2], x1[3]);
                    *(u32x4*)(xb + off) = w;
                    sq += (x0[0] * x0[0] + x0[1] * x0[1]) + (x0[2] * x0[2] + x0[3] * x0[3]) + (x1[0] * x1[0] + x1[1] * x1[1]) + (x1[2] * x1[2] + x1[3] * x1[3]); }
                sq = xq_sum(sq);
                if (fq == 0) ss[(size_t)row * 16 + u.pn * 4 + wc] = sq; }
            __builtin_amdgcn_sched_barrier(0);
        }
    }
};

struct EpiResidB {
    static constexpr bool PERM = true, AFTER_DRAIN = false;
    bf16_t* xb; float* ss; float asc;
    __device__ __forceinline__ void operator()(const f32x4 (&acc)[2][2][4][2], const Unit& u, int wr, int wc, int fr, int fq, int ui) const {
        const int row0 = u.pm * BM + wr * 64 + fr, col0 = u.pn * BM + wc * 32 + 8 * fq;
#pragma unroll
        for (int ai = 0; ai < 2; ++ai) {
            u32x4 xv[4][2];
#pragma unroll
            for (int m = 0; m < 4; ++m)
#pragma unroll
                for (int bj = 0; bj < 2; ++bj) xv[m][bj] = *(const u32x4*)(xb + (size_t)(row0 + ai * HALF + m * 16) * D_MODEL + col0 + bj * HALF);
            __builtin_amdgcn_sched_barrier(0);
#pragma unroll
            for (int m = 0; m < 4; ++m) { const int row = row0 + ai * HALF + m * 16; float sq = 0.f;
#pragma unroll
                for (int bj = 0; bj < 2; ++bj) { const size_t off = (size_t)row * D_MODEL + col0 + bj * HALF; const u32x4 v = xv[m][bj];
                    const f32x4 a0 = acc[ai][bj][m][0] * asc, a1 = acc[ai][bj][m][1] * asc;
                    u32x4 w; w.x = cvt_pk_bf16(bflo(v.x) + a0[0], bfhi(v.x) + a0[1]); w.y = cvt_pk_bf16(bflo(v.y) + a0[2], bfhi(v.y) + a0[3]);
                    w.z = cvt_pk_bf16(bflo(v.z) + a1[0], bfhi(v.z) + a1[1]); w.w = cvt_pk_bf16(bflo(v.w) + a1[2], bfhi(v.w) + a1[3]);
                    *(u32x4*)(xb + off) = w;
                    const float y0 = bflo(w.x), y1 = bfhi(w.x), y2 = bflo(w.y), y3 = bfhi(w.y), y4 = bflo(w.z), y5 = bfhi(w.z), y6 = bflo(w.w), y7 = bfhi(w.w);

                    sq += (y0 * y0 + y1 * y1) + (y2 * y2 + y3 * y3) + (y4 * y4 + y5 * y5) + (y6 * y6 + y7 * y7); }
                sq = xq_sum(sq);
                if (fq == 0) ss[(size_t)row * 16 + u.pn * 4 + wc] = sq; }
            __builtin_amdgcn_sched_barrier(0);
        }
    }
};

template <class Epi, class Sched, bool ALIGN_EPI = false, bool SP2 = false, int WIN = 0, bool F8 = false>
__device__ __forceinline__ void gemm_phase(PG8_LAS unsigned char* lds, const Gemm g, const Sched& S, const Epi& E, int wave_) {
    static_assert(!WIN || SP2, "WIN is written for the SP2 schedule");
    const int wid = wave_, lane = lane_id(), tid = wid * 64 + lane, wr = wid >> 2, wc = wid & 3, fr = lane & 15, fq = lane >> 4;
    const int K = g.K, nt = K / BK;
    constexpr int NT1 = 16;
    unsigned voffA[2], voffB[2], voffB2[2];
#pragma unroll
    for (int i = 0; i < 2; ++i) { int R, C; stage_rc(tid * 16 + i * 8192, R, C); const int Rb = Epi::PERM ? ((R & ~31) + perm32(R & 31)) : R;
        voffA[i] = (unsigned)(R * g.lda + C) * 2u;
        voffB[i] = WIN ? (unsigned)((Rb & 15) * 2048 + (7 - (Rb >> 4)) * 16 + C) * 2u : (unsigned)(Rb * g.ldb + C) * 2u;
        voffB2[i] = (unsigned)(Rb * 128 + C) * 2u; }
    const size_t kstep = (size_t)(BK * 2);
    const size_t hstepA = (size_t)HALF * g.lda * 2; const long hstepB = WIN ? -256L : (long)HALF * g.ldb * 2, hstepB2 = (long)HALF * 128 * 2;
    const size_t tstepA = 2 * hstepA; const long tstepB = 2 * hstepB, tstepB2 = 2 * hstepB2;
    const char* Bbase = (const char*)g.Bt + (WIN ? 56 * 32 : 0);
    const unsigned ldsw = (unsigned)wid * 1024u;
    const int aoff = lds_byte(wr * 64 + fr, F8 ? fq * 16 : fq * 8), boff = lds_byte(wc * 32 + fr, F8 ? fq * 16 : fq * 8);
#define PG8_SA(b, h) (((b) * 2 + (h)) * HTB)
#define PG8_SB(b, h) ((4 + (b) * 2 + (h)) * HTB)
#define PG8_STAGE(bufoff, gbase, voff) do { _Pragma("unroll") for (int _i = 0; _i < 2; ++_i) \
        __builtin_amdgcn_global_load_lds((const unsigned*)((const char*)(gbase) + (voff)[_i]), (PG8_LAS unsigned*)(lds + (bufoff) + ldsw + _i * 8192), 16, 0, 0); } while (0)
#define PG8_LD8(p_) __builtin_shufflevector(*(const PG8_LAS i32x4v*)(p_), *(const PG8_LAS i32x4v*)((p_) + 16), 0, 1, 2, 3, 4, 5, 6, 7)
#define PG8_LDA(dst, b, h) do { if constexpr (F8) { _Pragma("unroll") for (int m = 0; m < 4; ++m) dst##8[m] = PG8_LD8(lds + PG8_SA(b, h) + aoff + m * 2048); } \
        else { _Pragma("unroll") for (int m = 0; m < 4; ++m) _Pragma("unroll") for (int k = 0; k < 2; ++k) dst[m][k] = *(const PG8_LAS bf16x8*)(lds + PG8_SA(b, h) + aoff + m * 2048 + k * 1024); } } while (0)
#define PG8_LDB(dst, b, h) do { if constexpr (F8) { _Pragma("unroll") for (int n = 0; n < 2; ++n) dst##8[n] = PG8_LD8(lds + PG8_SB(b, h) + boff + n * 2048); } \
        else { _Pragma("unroll") for (int n = 0; n < 2; ++n) _Pragma("unroll") for (int k = 0; k < 2; ++k) dst[n][k] = *(const PG8_LAS bf16x8*)(lds + PG8_SB(b, h) + boff + n * 2048 + k * 1024); } } while (0)
#define PG8_SUB8(v, i0, i1) __builtin_bit_cast(long, __builtin_shufflevector(v, v, i0, i1))
#define PG8_MMA(ai, bj, At, Bt) do { __builtin_amdgcn_s_setprio(1); \
        if constexpr (F8) { _Pragma("unroll") for (int m = 0; m < 4; ++m) _Pragma("unroll") for (int n = 0; n < 2; ++n) { \
            acc[ai][bj][m][n] = __builtin_amdgcn_mfma_f32_16x16x32_fp8_fp8(PG8_SUB8(Bt##8[n], 0, 1), PG8_SUB8(At##8[m], 0, 1), acc[ai][bj][m][n], 0, 0, 0); \
            acc[ai][bj][m][n] = __builtin_amdgcn_mfma_f32_16x16x32_fp8_fp8(PG8_SUB8(Bt##8[n], 2, 3), PG8_SUB8(At##8[m], 2, 3), acc[ai][bj][m][n], 0, 0, 0); \
            acc[ai][bj][m][n] = __builtin_amdgcn_mfma_f32_16x16x32_fp8_fp8(PG8_SUB8(Bt##8[n], 4, 5), PG8_SUB8(At##8[m], 4, 5), acc[ai][bj][m][n], 0, 0, 0); \
            acc[ai][bj][m][n] = __builtin_amdgcn_mfma_f32_16x16x32_fp8_fp8(PG8_SUB8(Bt##8[n], 6, 7), PG8_SUB8(At##8[m], 6, 7), acc[ai][bj][m][n], 0, 0, 0); } } \
        else { _Pragma("unroll") for (int m = 0; m < 4; ++m) _Pragma("unroll") for (int n = 0; n < 2; ++n) _Pragma("unroll") for (int k = 0; k < 2; ++k) \
            acc[ai][bj][m][n] = __builtin_amdgcn_mfma_f32_16x16x32_bf16(Bt[n][k], At[m][k], acc[ai][bj][m][n], 0, 0, 0); } \
        __builtin_amdgcn_s_setprio(0); } while (0)
#define PG8_WAIT_V(n) asm volatile("s_waitcnt vmcnt(" #n ")" ::: "memory")
#define PG8_WAIT_L(n) asm volatile("s_waitcnt lgkmcnt(" #n ")" ::: "memory")
#define PG8_BAR __builtin_amdgcn_s_barrier()
#define PG8_SCHED __builtin_amdgcn_sched_barrier(0)
    Unit cur, nxt; int ui = 0;
    if (!S.next(0, cur)) return;
    f32x4 acc[2][2][4][2];
#pragma unroll
    for (int a = 0; a < 2; ++a)
#pragma unroll
        for (int b = 0; b < 2; ++b)
#pragma unroll
            for (int m = 0; m < 4; ++m)
#pragma unroll
                for (int n = 0; n < 2; ++n) acc[a][b][m][n] = (f32x4){0.f, 0.f, 0.f, 0.f};
    bf16x8 At[4][2], B0[2][2], B1[2][2]; i32x8v At8[4], B08[2], B18[2];
    const char* cA = (const char*)g.A + (size_t)cur.pm * tstepA; const char* cB = Bbase + (long)cur.pn * tstepB; const char* cB2 = (const char*)g.B2 + (long)cur.pn * tstepB2;
    S.a_ready(cur);
    if constexpr (SP2) {
        PG8_STAGE(PG8_SB(0, 0), cB, voffB); PG8_STAGE(PG8_SB(0, 1), cB + hstepB, voffB); PG8_STAGE(PG8_SA(0, 0), cA, voffA); PG8_STAGE(PG8_SA(0, 1), cA + hstepA, voffA);
        if (wr == 1) PG8_BAR;
        PG8_WAIT_V(2); PG8_BAR;
        PG8_STAGE(PG8_SB(1, 0), cB + kstep, voffB); PG8_STAGE(PG8_SA(1, 0), cA + kstep, voffA); PG8_STAGE(PG8_SB(1, 1), cB + hstepB + kstep, voffB);
        PG8_WAIT_V(6); PG8_BAR;
    } else {
        PG8_STAGE(PG8_SB(0, 0), cB, voffB); PG8_STAGE(PG8_SA(0, 0), cA, voffA); PG8_STAGE(PG8_SB(0, 1), cB + hstepB, voffB); PG8_STAGE(PG8_SA(0, 1), cA + hstepA, voffA);
        if (wr == 1) PG8_BAR;
        PG8_WAIT_V(4); PG8_BAR;
        PG8_STAGE(PG8_SB(1, 0), cB + kstep, voffB); PG8_STAGE(PG8_SA(1, 0), cA + kstep, voffA); PG8_STAGE(PG8_SB(1, 1), cB + hstepB + kstep, voffB);
        PG8_WAIT_V(6); PG8_BAR;
    }
    for (;;) {
        const bool has_next = S.next(ui + 1, nxt);
        const char* nA = has_next ? (const char*)g.A + (size_t)nxt.pm * tstepA : cA; const char* nB = has_next ? Bbase + (long)nxt.pn * tstepB : cB;
        const char* nB2 = has_next ? (const char*)g.B2 + (long)nxt.pn * tstepB2 : cB2;
        for (int t = 0; t < nt; t += 2) {
            const bool last = (t == nt - 2);
            const char* a1 = cA + (size_t)(t + 1) * kstep;
            const bool s2 = WIN && !last && (t + 2 >= NT1);
            const char* a2 = last ? nA : cA + (size_t)(t + 2) * kstep; const char* b2 = last ? nB : (s2 ? cB2 + (size_t)(t + 2 - NT1) * kstep : cB + (size_t)(t + 2) * kstep);
            const char* a3 = a2 + kstep; const char* b3 = b2 + kstep;
            unsigned vbs[2]; vbs[0] = s2 ? voffB2[0] : voffB[0]; vbs[1] = s2 ? voffB2[1] : voffB[1]; const long hbs = s2 ? hstepB2 : hstepB;
            if (last && has_next) S.a_ready(nxt);
            if constexpr (SP2) {
            PG8_LDB(B0, 0, 0); PG8_LDB(B1, 0, 1); PG8_SCHED; PG8_LDA(At, 0, 0); PG8_STAGE(PG8_SA(1, 1), a1 + hstepA, voffA);
            PG8_WAIT_V(8); PG8_WAIT_L(0); PG8_BAR; PG8_MMA(0, 0, At, B0); PG8_MMA(0, 1, At, B1); PG8_BAR; PG8_SCHED;
            PG8_LDA(At, 0, 1); PG8_STAGE(PG8_SB(0, 0), b2, vbs); PG8_STAGE(PG8_SB(0, 1), b2 + hbs, vbs); PG8_STAGE(PG8_SA(0, 0), a2, voffA);
            PG8_WAIT_V(8); PG8_WAIT_L(0); PG8_BAR; PG8_MMA(1, 0, At, B0); PG8_MMA(1, 1, At, B1); PG8_BAR; PG8_SCHED;
            PG8_LDB(B0, 1, 0); PG8_LDB(B1, 1, 1); PG8_SCHED; PG8_LDA(At, 1, 0); PG8_STAGE(PG8_SA(0, 1), a2 + hstepA, voffA);
            PG8_WAIT_V(8); PG8_WAIT_L(0); PG8_BAR; PG8_MMA(0, 0, At, B0); PG8_MMA(0, 1, At, B1); PG8_BAR; PG8_SCHED;
            PG8_LDA(At, 1, 1); PG8_STAGE(PG8_SB(1, 0), b3, vbs); PG8_STAGE(PG8_SB(1, 1), b3 + hbs, vbs); PG8_STAGE(PG8_SA(1, 0), a3, voffA);
            PG8_WAIT_V(8); PG8_WAIT_L(0); PG8_BAR; PG8_MMA(1, 0, At, B0); PG8_MMA(1, 1, At, B1); PG8_BAR; PG8_SCHED;
            } else {
            PG8_LDB(B0, 0, 0); PG8_SCHED; PG8_LDA(At, 0, 0); PG8_STAGE(PG8_SA(1, 1), a1 + hstepA, voffA);
            PG8_WAIT_L(8); PG8_BAR; PG8_WAIT_L(0); PG8_MMA(0, 0, At, B0); PG8_BAR; PG8_SCHED;
            PG8_LDB(B1, 0, 1); PG8_STAGE(PG8_SB(0, 0), b2, voffB);
            PG8_BAR; PG8_WAIT_L(0); PG8_MMA(0, 1, At, B1); PG8_BAR;
            PG8_LDA(At, 0, 1); PG8_STAGE(PG8_SA(0, 0), a2, voffA);
            PG8_BAR; PG8_WAIT_L(0); PG8_MMA(1, 0, At, B0); PG8_BAR; PG8_SCHED;
            PG8_STAGE(PG8_SB(0, 1), b2 + hstepB, voffB);
            PG8_WAIT_V(6); PG8_BAR; PG8_MMA(1, 1, At, B1); PG8_BAR;
            PG8_LDB(B0, 1, 0); PG8_SCHED; PG8_LDA(At, 1, 0); PG8_STAGE(PG8_SA(0, 1), a2 + hstepA, voffA);
            PG8_WAIT_L(8); PG8_BAR; PG8_WAIT_L(0); PG8_MMA(0, 0, At, B0); PG8_BAR; PG8_SCHED;
            PG8_LDB(B1, 1, 1); PG8_STAGE(PG8_SB(1, 0), b3, voffB);
            PG8_BAR; PG8_WAIT_L(0); PG8_MMA(0, 1, At, B1); PG8_BAR;
            PG8_LDA(At, 1, 1); PG8_STAGE(PG8_SA(1, 0), a3, voffA);
            PG8_BAR; PG8_WAIT_L(0); PG8_MMA(1, 0, At, B0); PG8_BAR; PG8_SCHED;
            PG8_STAGE(PG8_SB(1, 1), b3 + hstepB, voffB);
            PG8_WAIT_V(6); PG8_BAR; PG8_MMA(1, 1, At, B1); PG8_BAR;
            }
        }
        if constexpr (ALIGN_EPI) { if (wr == 0) PG8_BAR; }
        if constexpr (!Epi::AFTER_DRAIN) { const int l2_ = lane_id(); E(acc, cur, wr, wc, l2_ & 15, l2_ >> 4, ui); S.done(cur); }
        if (!has_next) break;
#pragma unroll
        for (int a = 0; a < 2; ++a)
#pragma unroll
            for (int b = 0; b < 2; ++b)
#pragma unroll
                for (int m = 0; m < 4; ++m)
#pragma unroll
                    for (int n = 0; n < 2; ++n) acc[a][b][m][n] = (f32x4){0.f, 0.f, 0.f, 0.f};
        cur = nxt; cA = nA; cB = nB; cB2 = nB2; ++ui;
        if constexpr (ALIGN_EPI) { if (wr == 1) PG8_BAR; }
    }
    PG8_WAIT_V(0);
    if constexpr (!ALIGN_EPI) { if (wr == 0) PG8_BAR; }
    PG8_BAR;
#undef PG8_SA
#undef PG8_SB
#undef PG8_STAGE
#undef PG8_LDA
#undef PG8_LDB
#undef PG8_MMA
#undef PG8_WAIT_V
#undef PG8_WAIT_L
#undef PG8_BAR
#undef PG8_SCHED
}
}

#define XB_TMO      128
#define XB_XCNT(j)  (256  + 64 * (j))
#define XB_XSUB(j)  (1280 + 64 * (j))
#define XB_XGEN(j)  (2304 + 64 * (j))
#define XB_TOP      3328
#define XB_TOPGEN   3392
#define XCD_BAR_WORDS 3456
#define XB_SPIN_CAP (1u << 18)
__device__ __forceinline__ unsigned xb_ld(unsigned* p)              { return __hip_atomic_load(p, __ATOMIC_RELAXED, __HIP_MEMORY_SCOPE_AGENT); }
__device__ __forceinline__ unsigned xb_add(unsigned* p, unsigned v) { return __hip_atomic_fetch_add(p, v, __ATOMIC_RELAXED, __HIP_MEMORY_SCOPE_AGENT); }
__device__ __forceinline__ unsigned xb_xcc_id() { return (unsigned)__builtin_amdgcn_s_getreg((3 << 11) | 20) & 0xFu; }
#define XB_SPIN(cond, bar) do { unsigned _sp = 0; while (cond) { __builtin_amdgcn_s_sleep(1); \
    if ((++_sp & 255u) == 0u) { if (xb_ld(&(bar)[XB_TMO])) break; if (_sp > XB_SPIN_CAP) { atomicAdd(&(bar)[XB_TMO], 1u); break; } } } } while (0)
struct XcdBarrier { unsigned* bar; unsigned x; volatile LAS unsigned* st; };
__device__ __forceinline__ XcdBarrier xcd_barrier_post(unsigned* bar, volatile LAS unsigned* st, bool leader) {
    XcdBarrier b; b.bar = bar; b.x = xb_xcc_id(); b.st = st;
    if (leader) (void)xb_add(&bar[XB_XCNT(b.x)], 1u);
    return b;
}
__device__ __forceinline__ void xcd_barrier_complete(unsigned* bar, unsigned x, unsigned& nloc, unsigned& nx) {
    const unsigned G = gridDim.x * gridDim.y * gridDim.z;
    unsigned sum, cnt, mine, sp = 0u;
    for (;;) {
        sum = 0u; cnt = 0u; mine = 0u;
#pragma unroll
        for (unsigned j = 0; j < 16; ++j) { const unsigned c = xb_ld(&bar[XB_XCNT(j)]); sum += c; cnt += (c > 0u) ? 1u : 0u; mine = (j == x) ? c : mine; }
        if (sum == G) break;
        __builtin_amdgcn_s_sleep(1);
        if ((++sp & 255u) == 0u) { if (xb_ld(&bar[XB_TMO])) break; if (sp > XB_SPIN_CAP) { atomicAdd(&bar[XB_TMO], 1u); break; } }
    }
    nloc = mine > 0u ? mine : 1u; nx = cnt > 0u ? cnt : 1u;
}
__device__ __forceinline__ void xcd_barrier(const XcdBarrier& b, bool leader) {
    asm volatile("s_waitcnt vmcnt(0)" ::: "memory");
    __syncthreads();
    if (leader) {
        unsigned* bar = b.bar;
        __builtin_amdgcn_s_waitcnt(0);
        unsigned nloc = b.st[0], nx = b.st[1];
        if (nloc == 0u) { xcd_barrier_complete(bar, b.x, nloc, nx); b.st[0] = nloc; b.st[1] = nx; }
        const unsigned old = xb_add(&bar[XB_XSUB(b.x)], 1u);
        const unsigned gen = old / nloc;
        if (old + 1u == (gen + 1u) * nloc) {
            __builtin_amdgcn_fence(__ATOMIC_RELEASE, "agent");
            asm volatile("s_waitcnt vmcnt(0)" ::: "memory");
            const unsigned og = xb_add(&bar[XB_TOP], 1u);
            const unsigned tg = og / nx;
            if (og + 1u == (tg + 1u) * nx) xb_add(&bar[XB_TOPGEN], 1u);
            else XB_SPIN(xb_ld(&bar[XB_TOPGEN]) == tg, bar);
            __builtin_amdgcn_fence(__ATOMIC_ACQUIRE, "agent");
            xb_add(&bar[XB_XGEN(b.x)], 1u);
            asm volatile("s_waitcnt vmcnt(0)" ::: "memory");
        } else {
            XB_SPIN(xb_ld(&bar[XB_XGEN(b.x)]) == gen, bar);
            __builtin_amdgcn_fence(__ATOMIC_ACQUIRE, "agent");
            asm volatile("s_waitcnt vmcnt(0)" ::: "memory");
        }
    }
    __syncthreads();
}

struct Args { const float* in[20]; float* out; unsigned char* ws; };
struct Frame {
    LAS unsigned char* lds;
    int tid, lane, wave, G, gw, NGW;
    unsigned char* ws;
};
#define MAKE_FRAME() Frame F; { F.lds = (LAS unsigned char*)lds_raw; F.wave = wave_id; F.lane = lane_id(); F.tid = wave_id * 64 + F.lane; \
    F.G = gridDim.x; F.gw = blockIdx.x * NWAVES + F.wave; F.NGW = F.G * NWAVES; F.ws = ws; }
__device__ __forceinline__ float wave_sum(float v) { return xq_sum(row_sum(v)); }
__device__ __forceinline__ float wave_max(float v) { return xq_max(row_max(v)); }

__device__ __forceinline__ int map_in(int j) {
    if (j < 896) return j;
    if (j < 960) return 1152 + (j - 896);
    if (j < 964) return 1216 + (j - 960);
    if (j < 1024) return -1;
    if (j < 1280) return 896 + (j - 1024);
    return 1220 + (j - 1280);
}
__device__ __forceinline__ int map_ffi(int r) { const int t = r >> 8, j = r & 255; return j < 128 ? t * 128 + j : D_FF + t * 128 + (j - 128); }
template <int MAP, bool F8 = false>
__device__ __forceinline__ void transpose_item(const float* W, int K, int N, int NT, const float* gain, bf16_t* WT, LAS float* scr, int item, int lane) {
    const int nblk = NT / 32, kb = item / nblk, nb = item % nblk, k0 = 64 * kb, n0 = 32 * nb;
    const int nn = n0 + (lane & 31);
    const int src = MAP == 0 ? nn : (MAP == 1 ? map_in(nn) : map_ffi(nn));
    const int srcc = src >= 0 ? src : 0;
#pragma unroll
    for (int hf = 0; hf < 2; ++hf) {
        float vv_[16], gg_[16];
#pragma unroll
        for (int i = 0; i < 16; ++i) { const int kk = 2 * (16 * hf + i) + (lane >> 5); vv_[i] = W[(size_t)(k0 + kk) * N + srcc]; gg_[i] = gain ? gain[k0 + kk] : 1.f; }
        __builtin_amdgcn_sched_barrier(0);
#pragma unroll
        for (int i = 0; i < 16; ++i) { const int kk = 2 * (16 * hf + i) + (lane >> 5); scr[kk * 33 + (lane & 31)] = src >= 0 ? vv_[i] * gg_[i] : 0.f; }
    }
    LDS_WAIT();
    const int c = lane & 7;
#pragma unroll
    for (int j = 0; j < 4; ++j) { const int n = (lane >> 3) + 8 * j; const LAS float* s = scr + (8 * c) * 33 + n;
        if constexpr (F8) { u32x2 o8; o8.x = pk4_f8(s[0 * 33] * F8_WS, s[1 * 33] * F8_WS, s[2 * 33] * F8_WS, s[3 * 33] * F8_WS); o8.y = pk4_f8(s[4 * 33] * F8_WS, s[5 * 33] * F8_WS, s[6 * 33] * F8_WS, s[7 * 33] * F8_WS);
            *(u32x2*)((unsigned char*)WT + (size_t)(n0 + n) * K + k0 + 8 * c) = o8; }
        else { u32x4 o; o.x = pk2(s[0 * 33], s[1 * 33]); o.y = pk2(s[2 * 33], s[3 * 33]); o.z = pk2(s[4 * 33], s[5 * 33]); o.w = pk2(s[6 * 33], s[7 * 33]);
        *(u32x4*)(WT + (size_t)(n0 + n) * K + k0 + 8 * c) = o; } }
    LDS_WAIT();
}

__device__ __forceinline__ float gelu_tanh(float y) {
    const float t = 0.7978845608028654f * (y + 0.044715f * y * y * y);
    const float e = __expf(2.0f * t);
    const float th = 1.0f - 2.0f / (e + 1.0f);
    return 0.5f * y * (1.0f + th);
}

__device__ __forceinline__ void s5_expand(const Frame& F, const Args& a, int l) {
    const float* tab = (const float*)(F.ws + WS_TAB);
    const float* POW = tab + TB_POW / 4 + (size_t)l * S5_G * S5_N * 65 * 2;
    const float* KC = tab + TB_KC / 4 + (size_t)l * S5_G * 64 * 256;
    const float* BB = tab + TB_S5BB / 4 + (size_t)l * S5_G * S5_N * 32;
    const float* CC = tab + TB_S5C / 4 + (size_t)l * S5_G * S5_N * 32;
    bf16_t* M = (bf16_t*)(F.ws + WS_S5M); bf16_t* W = (bf16_t*)(F.ws + WS_S5W);
    const int gt = blockIdx.x * (NWAVES * 64) + F.tid, NT = F.G * NWAVES * 64;
    for (int i = gt; i < S5_G * 16 * 128 * 2; i += NT) {
        const int qh = i & 1, e = (i >> 1) & 127, p = (i >> 8) & 15, g = i >> 12;
        float v[8];
        if (e <= 63) { const float* kp = KC + ((size_t)(g * 64 + (63 - e)) * 16 + p) * 16 + 8 * qh; const f32x4 k0 = *(const f32x4*)kp, k1 = *(const f32x4*)(kp + 4);
            v[0] = k0[0]; v[1] = k0[1]; v[2] = k0[2]; v[3] = k0[3]; v[4] = k1[0]; v[5] = k1[1]; v[6] = k1[2]; v[7] = k1[3];
            if (e == 63 && (p >> 3) == qh) { const float dsk = a.in[11][(size_t)(l * S5_G + g) * S5_P + p];
#pragma unroll
                for (int j = 0; j < 8; ++j) v[j] += ((p & 7) == j) ? dsk : 0.f; } }
        else {
#pragma unroll
            for (int j = 0; j < 8; ++j) v[j] = 0.f; }
        u32x4 o; o.x = pk2(v[0], v[1]); o.y = pk2(v[2], v[3]); o.z = pk2(v[4], v[5]); o.w = pk2(v[6], v[7]);
        *(u32x4*)(M + ((size_t)(g * 16 + p) * 128 + e) * 16 + 8 * qh) = o;
    }
    for (int i = gt; i < S5_G * 1024 * 16; i += NT) {
        const int cks = i & 15, row = (i >> 4) & 1023, g = i >> 14, tau = row >> 4, p = row & 15; const bool im = cks >= 8; const int n0 = (cks & 7) * 8;
        float v[8];
#pragma unroll
        for (int j = 0; j < 8; ++j) { const int n = n0 + j; const float* pw = POW + ((size_t)(g * S5_N + n) * 65 + (tau + 1)) * 2; const float* cp = CC + ((size_t)(g * S5_N + n) * 16 + p) * 2;
            const float pr = pw[0], pi = pw[1], cr = cp[0], ci = cp[1];
            v[j] = im ? -(cr * pi + ci * pr) : (cr * pr - ci * pi); }
        u32x4 o; o.x = pk2(v[0], v[1]); o.y = pk2(v[2], v[3]); o.z = pk2(v[4], v[5]); o.w = pk2(v[6], v[7]);
        *(u32x4*)(M + S5_KR_ELEMS + ((size_t)g * 1024 + row) * 128 + cks * 8) = o;
    }
    for (int i = gt; i < S5_G * 256 * 128; i += NT) {
        const int ck = i & 127, row = (i >> 7) & 255, g = i >> 15, sg = ck >> 1, q0 = (ck & 1) * 8;
        float v[8];
        if (row < 128) { const int n = row & 63; const bool im = row >= 64;
            const float* pw = POW + ((size_t)(g * S5_N + n) * 65 + (63 - sg)) * 2; const float pr = pw[0], pi = pw[1];
            const float* bp = BB + ((size_t)(g * S5_N + n) * 16 + q0) * 2;
#pragma unroll
            for (int j = 0; j < 8; ++j) { const float br = bp[2 * j], bi = bp[2 * j + 1]; v[j] = im ? (pr * bi + pi * br) : (pr * br - pi * bi); } }
        else {
#pragma unroll
            for (int j = 0; j < 8; ++j) v[j] = 0.f; }
        u32x4 o; o.x = pk2(v[0], v[1]); o.y = pk2(v[2], v[3]); o.z = pk2(v[4], v[5]); o.w = pk2(v[6], v[7]);
        *(u32x4*)(W + ((size_t)g * 256 + row) * 1024 + ck * 8) = o;
    }
}
__device__ __forceinline__ void s5_unit(unsigned char* ws_, int wave_id, int l, int g, int mh) {
    extern __shared__ __attribute__((aligned(16))) unsigned char lds_raw[];
    g = __builtin_amdgcn_readfirstlane(g); mh = __builtin_amdgcn_readfirstlane(mh); asm volatile("" : "+s"(g), "+s"(mh));
    unsigned char* ws = ws_; MAKE_FRAME();
    bf16_t* U = (bf16_t*)(F.ws + WS_S5U) + (size_t)g * 512 * S5K;
    const bf16_t* W = (const bf16_t*)(F.ws + WS_S5W) + (size_t)g * 256 * 1024;
    const bf16_t* KR = (const bf16_t*)(F.ws + WS_S5M) + (size_t)g * 16 * 128 * 16; const bf16_t* B2 = (const bf16_t*)(F.ws + WS_S5M) + S5_KR_ELEMS + (size_t)g * 1024 * 128;
    float* E = (float*)(F.ws + WS_S5E) + (size_t)blockIdx.x * 256 * 128;
    {   pg8::Gemm gm{U, W, S5K, 1024, 1024}; pg8::SingleUnit S{mh, 0}; pg8::EpiS5State Ep{E};
        pg8::gemm_phase<pg8::EpiS5State, pg8::SingleUnit, false, true>(F.lds, gm, S, Ep, F.wave); }
    __syncthreads();
    const int tid2 = wave_id * 64 + lane_id();
    if (tid2 < 256) {
        const int bl = tid2 >> 6, n = tid2 & 63;
        const float* pw = (const float*)(F.ws + WS_TAB) + TB_POW / 4 + ((size_t)((l * S5_G + g) * S5_N + n) * 65 + 64) * 2;
        const float lr = pw[0], li = pw[1];
        float hr = 0.f, hi = 0.f;
        for (int c0 = 0; c0 < 64; c0 += 16) {
            float er[16], ei[16];
#pragma unroll
            for (int j = 0; j < 16; ++j) { const int r = bl * 64 + c0 + j; er[j] = E[(size_t)r * 128 + n]; ei[j] = E[(size_t)r * 128 + 64 + n]; }
#pragma unroll
            for (int j = 0; j < 16; ++j) {
                const int r = bl * 64 + c0 + j;
                bf16_t* up = U + (size_t)(mh * 256 + r) * S5K + 1024;
                up[n] = (bf16_t)f2bf(hr); up[64 + n] = (bf16_t)f2bf(hi);
                const float nr = lr * hr - li * hi + er[j], ni = lr * hi + li * hr + ei[j];
                hr = nr; hi = ni;
            }
        }
    }
    VM_WAIT();
    __syncthreads();
    {   pg8::Gemm gm{U, KR, S5K, 0, S5K, B2}; pg8::RowUnits S{mh, 4}; pg8::EpiS5Y Ep{(bf16_t*)(F.ws + WS_YG), g};
        pg8::gemm_phase<pg8::EpiS5Y, pg8::RowUnits, true, true, 1>(F.lds, gm, S, Ep, F.wave); }
}

typedef short s16x4 __attribute__((ext_vector_type(4)));
constexpr int RT_Q = 0, RT_KA = 16384, RT_KB = 32768, RT_V = 49152, RT_S = 65536;
__device__ __forceinline__ s16x4 tr_rd(LAS unsigned char* p) { return __builtin_bit_cast(s16x4, __builtin_amdgcn_ds_read_tr16_b64_v4i16((LAS s16x4*)p)); }
__device__ __forceinline__ int swzA(int row, int colb) { return row * 128 + (colb ^ ((row & 7) << 4)); }
__device__ __forceinline__ int swzB(int row, int colb) { return row * 128 + (colb ^ (((row >> 1) & 3) << 5)); }
__device__ __forceinline__ void ret_unit(unsigned char* ws_, int wave_id, const float* gn, int l, int b, int h) {
    extern __shared__ __attribute__((aligned(16))) unsigned char lds_raw[];
    b = __builtin_amdgcn_readfirstlane(b); h = __builtin_amdgcn_readfirstlane(h); asm volatile("" : "+s"(b), "+s"(h));
    unsigned char* ws = ws_; MAKE_FRAME();
    const int tid = F.tid, lane = F.lane, w = F.wave, fr = lane & 15, fq = lane >> 4;
    LAS unsigned char* L = F.lds;
    const bf16_t* proj = (const bf16_t*)(F.ws + WS_PROJ);
    bf16_t* mix = (bf16_t*)(F.ws + WS_MIX);
    const float* rope = (const float*)(F.ws + WS_TAB + TB_ROPE);
    const float gamma = 1.0f - exp2f(-5.0f - (float)h), lg2 = log2f(gamma);
    const float g127 = exp2f(127.0f * lg2), g128 = g127 * gamma;
    const int trow = (tid & 255) >> 1, tp = tid & 1; const bool isk = tid >= 256;
    const int vrow = tid >> 2, vpart = tid & 3;
    const size_t colqk = (size_t)(isk ? PC_RK : PC_RQ) + h * 64 + 16 * tp;
    f32x4 sacc[2];
    sacc[0] = (f32x4){0.f, 0.f, 0.f, 0.f}; sacc[1] = sacc[0];
    for (int i = tid; i < 8192 / 4; i += NWAVES * 64) ((LAS unsigned*)(L + RT_S))[i] = 0u;
    u32x4 rq[4], rv[2];
    {   const bf16_t* p0 = proj + (size_t)(b * SEQ + trow) * NPROJ + colqk;
        rq[0] = *(const u32x4*)p0; rq[1] = *(const u32x4*)(p0 + 8); rq[2] = *(const u32x4*)(p0 + 32); rq[3] = *(const u32x4*)(p0 + 40);
        const bf16_t* pv = proj + (size_t)(b * SEQ + vrow) * NPROJ + PC_RV + h * 64 + 16 * vpart;
        rv[0] = *(const u32x4*)pv; rv[1] = *(const u32x4*)(pv + 8); }
    for (int c = 0; c < SEQ / 128; ++c) {
        {
            const int pos = c * 128 + trow;
            const float sc = isk ? exp2f(-(float)trow * lg2) * 0.125f : exp2f((float)trow * lg2);
            const float* rp = rope + ((size_t)pos * 32 + 16 * tp) * 2;
            float x1[16], x2[16];
            const unsigned wa[8] = {rq[0].x, rq[0].y, rq[0].z, rq[0].w, rq[1].x, rq[1].y, rq[1].z, rq[1].w};
            const unsigned wb[8] = {rq[2].x, rq[2].y, rq[2].z, rq[2].w, rq[3].x, rq[3].y, rq[3].z, rq[3].w};
#pragma unroll
            for (int i = 0; i < 8; ++i) { x1[2 * i] = bflo(wa[i]); x1[2 * i + 1] = bfhi(wa[i]); x2[2 * i] = bflo(wb[i]); x2[2 * i + 1] = bfhi(wb[i]); }
            unsigned o1[8], o2[8];
#pragma unroll
            for (int i = 0; i < 8; ++i) {
                const f32x4 cs = *(const f32x4*)(rp + 4 * i);
                const float a0 = (x1[2 * i] * cs[0] - x2[2 * i] * cs[1]) * sc, a1 = (x1[2 * i + 1] * cs[2] - x2[2 * i + 1] * cs[3]) * sc;
                const float b0 = (x2[2 * i] * cs[0] + x1[2 * i] * cs[1]) * sc, b1 = (x2[2 * i + 1] * cs[2] + x1[2 * i + 1] * cs[3]) * sc;
                o1[i] = pk2(a0, a1); o2[i] = pk2(b0, b1); }
            const u32x4 p0 = {o1[0], o1[1], o1[2], o1[3]}, p1 = {o1[4], o1[5], o1[6], o1[7]}, p2 = {o2[0], o2[1], o2[2], o2[3]}, p3 = {o2[4], o2[5], o2[6], o2[7]};
            const int cb = 32 * tp;
            if (!isk) {
                *(LAS u32x4*)(L + RT_Q + swzA(trow, cb)) = p0; *(LAS u32x4*)(L + RT_Q + swzA(trow, cb + 16)) = p1;
                *(LAS u32x4*)(L + RT_Q + swzA(trow, cb + 64)) = p2; *(LAS u32x4*)(L + RT_Q + swzA(trow, cb + 80)) = p3;
            } else {
                *(LAS u32x4*)(L + RT_KA + swzA(trow, cb)) = p0; *(LAS u32x4*)(L + RT_KA + swzA(trow, cb + 16)) = p1;
                *(LAS u32x4*)(L + RT_KA + swzA(trow, cb + 64)) = p2; *(LAS u32x4*)(L + RT_KA + swzA(trow, cb + 80)) = p3;
                *(LAS u32x4*)(L + RT_KB + swzB(trow, cb)) = p0; *(LAS u32x4*)(L + RT_KB + swzB(trow, cb + 16)) = p1;
                *(LAS u32x4*)(L + RT_KB + swzB(trow, cb + 64)) = p2; *(LAS u32x4*)(L + RT_KB + swzB(trow, cb + 80)) = p3;
            }
            *(LAS u32x4*)(L + RT_V + swzB(vrow, 32 * vpart)) = rv[0]; *(LAS u32x4*)(L + RT_V + swzB(vrow, 32 * vpart + 16)) = rv[1];
        }
        __syncthreads();
        if (c + 1 < SEQ / 128) {
            const bf16_t* p0 = proj + (size_t)(b * SEQ + (c + 1) * 128 + trow) * NPROJ + colqk;
            rq[0] = *(const u32x4*)p0; rq[1] = *(const u32x4*)(p0 + 8); rq[2] = *(const u32x4*)(p0 + 32); rq[3] = *(const u32x4*)(p0 + 40);
            const bf16_t* pv = proj + (size_t)(b * SEQ + (c + 1) * 128 + vrow) * NPROJ + PC_RV + h * 64 + 16 * vpart;
            rv[0] = *(const u32x4*)pv; rv[1] = *(const u32x4*)(pv + 8); }
        const size_t tok = (size_t)b * SEQ + c * 128 + 16 * w + fr;
        u32x2 gv[4];
#pragma unroll
        for (int et = 0; et < 4; ++et) gv[et] = *(const u32x2*)(proj + tok * NPROJ + PC_RG + h * 64 + 16 * et + 4 * fq);
        bf16x8 qf[2];
#pragma unroll
        for (int ks = 0; ks < 2; ++ks) qf[ks] = *(const LAS bf16x8*)(L + RT_Q + swzA(16 * w + fr, 16 * fq + 64 * ks));
        f32x4 accO[4], accX[4];
#pragma unroll
        for (int et = 0; et < 4; ++et) { accO[et] = (f32x4){0.f, 0.f, 0.f, 0.f}; accX[et] = accO[et]; }
        const int npair = (w + 2) >> 1;
        for (int pr = 0; pr < npair; ++pr) {
            const int T0 = 2 * pr, T1 = 2 * pr + 1;
            f32x4 s0 = (f32x4){0.f, 0.f, 0.f, 0.f}, s1 = s0;
#pragma unroll
            for (int ks = 0; ks < 2; ++ks) {
                const bf16x8 k0 = *(const LAS bf16x8*)(L + RT_KA + swzA(16 * T0 + fr, 16 * fq + 64 * ks));
                const bf16x8 k1 = *(const LAS bf16x8*)(L + RT_KA + swzA(16 * T1 + fr, 16 * fq + 64 * ks));
                s0 = __builtin_amdgcn_mfma_f32_16x16x32_bf16(k0, qf[ks], s0, 0, 0, 0);
                s1 = __builtin_amdgcn_mfma_f32_16x16x32_bf16(k1, qf[ks], s1, 0, 0, 0);
            }
#pragma unroll
            for (int r = 0; r < 4; ++r) {
                const bool k0ok = (T0 < w) || (T0 == w && 4 * fq + r <= fr);
                const bool k1ok = (T1 < w) || (T1 == w && 4 * fq + r <= fr);
                s0[r] = k0ok ? s0[r] : 0.f; s1[r] = k1ok ? s1[r] : 0.f; }
            u32x4 pw; pw.x = pk2(s0[0], s0[1]); pw.y = pk2(s0[2], s0[3]); pw.z = pk2(s1[0], s1[1]); pw.w = pk2(s1[2], s1[3]);
            const bf16x8 pb = __builtin_bit_cast(bf16x8, pw);
#pragma unroll
            for (int et = 0; et < 4; ++et) {
                const s16x4 v0 = tr_rd(L + RT_V + swzB(16 * T0 + 4 * fq + (fr >> 2), 32 * et + 8 * (fr & 3)));
                const s16x4 v1 = tr_rd(L + RT_V + swzB(16 * T1 + 4 * fq + (fr >> 2), 32 * et + 8 * (fr & 3)));
                const bf16x8 va = __builtin_shufflevector(v0, v1, 0, 1, 2, 3, 4, 5, 6, 7);
                accO[et] = __builtin_amdgcn_mfma_f32_16x16x32_bf16(va, pb, accO[et], 0, 0, 0);
            }
        }
#pragma unroll
        for (int et = 0; et < 4; ++et)
#pragma unroll
            for (int ks = 0; ks < 2; ++ks) {
                const bf16x8 sf = *(const LAS bf16x8*)(L + RT_S + swzA(16 * et + fr, 16 * fq + 64 * ks));
                accX[et] = __builtin_amdgcn_mfma_f32_16x16x32_bf16(sf, qf[ks], accX[et], 0, 0, 0);
            }
        f32x4 tmp[2];
#pragma unroll
        for (int x = 0; x < 2; ++x) {
            const int tt = 2 * w + x, et = tt >> 2, dt = tt & 3;
            tmp[x] = (f32x4){0.f, 0.f, 0.f, 0.f};
#pragma unroll
            for (int ks = 0; ks < 4; ++ks) {
                const int j0 = 32 * ks + 4 * fq + (fr >> 2), j1 = j0 + 16;
                const s16x4 v0 = tr_rd(L + RT_V + swzB(j0, 32 * et + 8 * (fr & 3))), v1 = tr_rd(L + RT_V + swzB(j1, 32 * et + 8 * (fr & 3)));
                const s16x4 k0 = tr_rd(L + RT_KB + swzB(j0, 32 * dt + 8 * (fr & 3))), k1 = tr_rd(L + RT_KB + swzB(j1, 32 * dt + 8 * (fr & 3)));
                const bf16x8 va = __builtin_shufflevector(v0, v1, 0, 1, 2, 3, 4, 5, 6, 7), kb = __builtin_shufflevector(k0, k1, 0, 1, 2, 3, 4, 5, 6, 7);
                tmp[x] = __builtin_amdgcn_mfma_f32_16x16x32_bf16(va, kb, tmp[x], 0, 0, 0);
            }
            sacc[x] = sacc[x] * g128 + tmp[x] * g127;
        }
        __syncthreads();
#pragma unroll
        for (int x = 0; x < 2; ++x) { const int tt = 2 * w + x, et = tt >> 2, dt = tt & 3;
#pragma unroll
            for (int r = 0; r < 4; ++r) { const int e = 16 * et + 4 * fq + r, d = 16 * dt + fr;
                *(LAS unsigned short*)(L + RT_S + swzA(e, 2 * d)) = (unsigned short)f2bf(sacc[x][r]); } }
        float o[16]; float s = 0.f;
#pragma unroll
        for (int et = 0; et < 4; ++et)
#pragma unroll
            for (int r = 0; r < 4; ++r) { o[4 * et + r] = accO[et][r] + gamma * accX[et][r]; s += o[4 * et + r]; }
        s = xq_sum(s);
        const float mu = s * (1.0f / 64.0f); float q2 = 0.f;
#pragma unroll
        for (int i = 0; i < 16; ++i) { o[i] -= mu; q2 += o[i] * o[i]; }
        q2 = xq_sum(q2);
        const float rstd = 1.0f / sqrtf(q2 * (1.0f / 64.0f) + GN_EPS);
#pragma unroll
        for (int et = 0; et < 4; ++et) {
            const f32x4 gw = *(const f32x4*)(gn + (size_t)l * 256 + h * 64 + 16 * et + 4 * fq);
            const float g0 = bflo(gv[et].x), g1 = bfhi(gv[et].x), g2 = bflo(gv[et].y), g3 = bfhi(gv[et].y);
            const float y0 = g0 / (1.0f + __expf(-g0)) * o[4 * et] * rstd * gw[0], y1 = g1 / (1.0f + __expf(-g1)) * o[4 * et + 1] * rstd * gw[1];
            const float y2 = g2 / (1.0f + __expf(-g2)) * o[4 * et + 2] * rstd * gw[2], y3 = g3 / (1.0f + __expf(-g3)) * o[4 * et + 3] * rstd * gw[3];
            u32x2 ow; ow.x = pk2(y0, y1); ow.y = pk2(y2, y3);
            *(u32x2*)(mix + tok * 1024 + 768 + h * 64 + 16 * et + 4 * fq) = ow;
        }
    }
    __syncthreads();
}

__device__ __forceinline__ void glds16(const void* gsrc, unsigned lds_dst) {
    unsigned keep;
    asm volatile("s_mov_b32 %0, m0\n\ts_mov_b32 m0, %2\n\ts_nop 0\n\tglobal_load_lds_dwordx4 %1, off\n\ts_mov_b32 m0, %0" : "=&s"(keep) : "v"(gsrc), "s"(lds_dst) : "memory");
}
__device__ __forceinline__ void glds4(const void* gsrc, unsigned lds_dst) {
    unsigned keep;
    asm volatile("s_mov_b32 %0, m0\n\ts_mov_b32 m0, %2\n\ts_nop 0\n\tglobal_load_lds_dword %1, off\n\ts_mov_b32 m0, %0" : "=&s"(keep) : "v"(gsrc), "s"(lds_dst) : "memory");
}
__device__ __forceinline__ unsigned fkey(float f) { const unsigned u = __builtin_bit_cast(unsigned, f); return (u & 0x80000000u) ? ~u : (u | 0x80000000u); }
constexpr int DS_KBUF = 0, DS_HIST = 32768, DS_TIE = 32768, DS_VST1 = 65536, DS_CAND = 65536, DS_BITS = 98304, DS_WMISC = 131072, DS_LUT = 139264, DS_THR = 143360, DS_RED = 144384;
constexpr int DW_LIST = 0, DW_PFX = 512, DW_SCR = 768;
struct DsaQ {
    bf16x8 Bq[4][2];
    float lo[4], hi[4];
    float inv; int ZB;
};
__device__ __forceinline__ void dsa_build_q(DsaQ& Q, const bf16_t* proj, const bf16_t* kvb, size_t tok, int fq, float krms) {
    asm volatile("" : "+v"(fq));
    const bf16_t* prow = proj + tok * NPROJ;
    const u32x2 wv = *(const u32x2*)(kvb + tok * KV_LD + KV_IW);
    const float wh[4] = {bflo(wv.x) * 0.0625f, bfhi(wv.x) * 0.0625f, bflo(wv.y) * 0.0625f, bfhi(wv.y) * 0.0625f};
    float hi_sum = 0.f, lo_sum = 0.f;
#pragma unroll
    for (int h = 0; h < 4; ++h) {
        float sq = 0.f;
#pragma unroll
        for (int ks = 0; ks < 2; ++ks) {
            const u32x4 v = *(const u32x4*)(prow + PC_IQ + h * 64 + 8 * fq + 32 * ks);
            const unsigned w4[4] = {v.x, v.y, v.z, v.w}; unsigned o4[4];
#pragma unroll
            for (int j = 0; j < 4; ++j) { const float a = bflo(w4[j]), c = bfhi(w4[j]); sq += a * a + c * c; o4[j] = pk2(a * wh[h], c * wh[h]); }
            const u32x4 ov = {o4[0], o4[1], o4[2], o4[3]};
            Q.Bq[h][ks] = __builtin_bit_cast(bf16x8, ov);
        }
        sq = xq_sum(sq);
        const float rng = fabsf(wh[h]) * sqrtf(sq) * krms * 3.0f;
        const bool pos = wh[h] > 0.f;
        Q.lo[h] = pos ? 0.f : -__builtin_inff(); Q.hi[h] = pos ? __builtin_inff() : 0.f;
        if (pos) hi_sum += rng; else lo_sum += rng;
    }
    const float R = fmaxf(hi_sum, lo_sum);
    Q.inv = R > 0.f ? 16129.0f / R : 0.f;
    Q.ZB = 128;
}
__device__ __forceinline__ float dsa_score_raw(const DsaQ& Q, const f32x4 (&acc)[4], int r) {
    return (__builtin_amdgcn_fmed3f(acc[0][r], Q.lo[0], Q.hi[0]) + __builtin_amdgcn_fmed3f(acc[1][r], Q.lo[1], Q.hi[1])) + (__builtin_amdgcn_fmed3f(acc[2][r], Q.lo[2], Q.hi[2]) + __builtin_amdgcn_fmed3f(acc[3][r], Q.lo[3], Q.hi[3]));
}
__device__ __forceinline__ unsigned pk_h2(float a, float b) { return __builtin_bit_cast(unsigned, __builtin_amdgcn_cvt_pkrtz(a, b)); }
__device__ __forceinline__ float h16f(unsigned bits) { return (float)__builtin_bit_cast(_Float16, (unsigned short)bits); }
__device__ __forceinline__ float dsa_score(const DsaQ& Q, const f32x4 (&acc)[4], int r) { return h16f(pk_h2(dsa_score_raw(Q, acc, r), 0.f) & 0xffffu); }
__device__ __forceinline__ float dsa_binf_inv(float inv, float s) {
    const float m = fminf(__builtin_ceilf(__builtin_amdgcn_sqrtf(fabsf(s) * inv)), 127.0f);
    return __builtin_copysignf(m, s);
}
__device__ __forceinline__ float dsa_binf(const DsaQ& Q, float s) {
    return dsa_binf_inv(Q.inv, s);
}
template <int MODE>
__device__ __forceinline__ void dsa_pass(LAS unsigned char* L, const bf16_t* ikb, int qb, int wave, int lane, const DsaQ& Q, int tq, int bstar, u32x2* sc) {
    const int fr = lane & 15, fq = lane >> 4, qg = wave & 3, kh = wave >> 2, qloc = 16 * qg + fr;
    const int ntile = (qb + 2) >> 1;
    const float bstarf = (float)(bstar - 128);
    const int drow = 8 * wave + (lane >> 3), dch = lane & 7;
    const size_t src0 = (size_t)drow * KV_LD * 2 + (size_t)((dch ^ (drow & 7)) * 16), src1 = src0 + (size_t)64 * KV_LD * 2;
    const unsigned kb_lds = (unsigned)__builtin_amdgcn_readfirstlane((int)(unsigned)(size_t)(L + DS_KBUF + wave * 1024));
#define DSA_STAGE(kt_, buf_) do { const char* tb_ = (const char*)ikb + (size_t)(kt_) * 128 * KV_LD * 2; \
        glds16(tb_ + src0, kb_lds + (buf_) * 16384); glds16(tb_ + src1, kb_lds + (buf_) * 16384 + 8192); } while (0)
    DSA_STAGE(0, 0);
    for (int kt = 0; kt < ntile; ++kt) {
        asm volatile("s_waitcnt vmcnt(0)" ::: "memory");
        __syncthreads();
        if (kt + 1 < ntile) DSA_STAGE(kt + 1, (kt + 1) & 1);
        LAS unsigned char* buf = L + DS_KBUF + (kt & 1) * 16384;
        const bool last = (kt == ntile - 1);
#define PASS_TILE(LASTT) \
        _Pragma("unroll 1") for (int si = 0; si < 4; ++si) { \
            const int sub = 2 * si + kh; \
            f32x4 acc[4]; \
            _Pragma("unroll") \
            for (int h = 0; h < 4; ++h) acc[h] = (f32x4){0.f, 0.f, 0.f, 0.f}; \
            _Pragma("unroll") \
            for (int ks = 0; ks < 2; ++ks) { \
                const bf16x8 a = *(const LAS bf16x8*)(buf + swzA(16 * sub + fr, 16 * fq + 64 * ks)); \
            _Pragma("unroll") \
                for (int h = 0; h < 4; ++h) acc[h] = __builtin_amdgcn_mfma_f32_16x16x32_bf16(a, Q.Bq[h][ks], acc[h], 0, 0, 0); \
            } \
            const int key0 = 128 * kt + 16 * sub + 4 * fq; \
            unsigned msel = 0u, mtie = 0u; \
            LAS unsigned* hq = (LAS unsigned*)(L + DS_HIST) + qloc * 256 + 128; \
            u32x2 pkv_; pkv_.x = pk_h2(dsa_score_raw(Q, acc, 0), dsa_score_raw(Q, acc, 1)); pkv_.y = pk_h2(dsa_score_raw(Q, acc, 2), dsa_score_raw(Q, acc, 3)); \
            if (MODE == 1) sc[(size_t)((kt * 8 + wave) * 4 + si) * 64 + lane] = pkv_; \
            const float s4_[4] = {h16f(pkv_.x & 0xffffu), h16f(pkv_.x >> 16), h16f(pkv_.y & 0xffffu), h16f(pkv_.y >> 16)}; \
            _Pragma("unroll") \
            for (int r = 0; r < 4; ++r) { \
                const float s = s4_[r]; \
                const float bf = dsa_binf(Q, s); \
                const bool valid = !(LASTT) || (key0 + r <= tq); \
                if (MODE == 1) { __hip_atomic_fetch_add(hq + (int)bf, valid ? 1u : 0u, __ATOMIC_RELAXED, __HIP_MEMORY_SCOPE_WORKGROUP); } \
                else { msel |= (valid && bf > bstarf) ? (1u << r) : 0u; const bool tie = valid && bf == bstarf; mtie |= tie ? (1u << r) : 0u; \
                    if (tie) { \
                        const unsigned slot = __hip_atomic_fetch_add((LAS unsigned*)(L + DS_THR) + 4 * qloc + 3, 1u, __ATOMIC_RELAXED, __HIP_MEMORY_SCOPE_WORKGROUP); \
                        if (slot < 64u) { u32x2 e; e.x = fkey(s); e.y = (unsigned)(key0 + r); *((LAS u32x2*)(L + DS_CAND) + qloc * 64 + slot) = e; } } } \
            } \
            if (MODE == 2) { \
                const int wd = key0 >> 5, sh = key0 & 31; \
                if (msel) __hip_atomic_fetch_or((LAS unsigned*)(L + DS_BITS) + qloc * 128 + wd, msel << sh, __ATOMIC_RELAXED, __HIP_MEMORY_SCOPE_WORKGROUP); \
                if (mtie) __hip_atomic_fetch_or((LAS unsigned*)(L + DS_TIE) + qloc * 128 + wd, mtie << sh, __ATOMIC_RELAXED, __HIP_MEMORY_SCOPE_WORKGROUP); \
            } \
        }
        if (last) { PASS_TILE(true) } else { PASS_TILE(false) }
#undef PASS_TILE
    }
#undef DSA_STAGE
    __syncthreads();
}
__device__ __forceinline__ void dsa_pass2s(LAS unsigned char* L, const u32x2* sc, int qb, int wave, int lane, int tq, float shi, float slo) {
    const int fr = lane & 15, fq = lane >> 4, qg = wave & 3, kh = wave >> 2, qloc = 16 * qg + fr;
    const int ntile = (qb + 2) >> 1;
    const u32x2* sp = sc + (size_t)wave * 256 + lane;
    u32x2 cur[4], nxt[4];
#pragma unroll
    for (int si = 0; si < 4; ++si) { cur[si] = sp[si * 64]; nxt[si] = cur[si]; }
#pragma unroll 1
    for (int kt = 0; kt < ntile; ++kt) {
        if (kt + 1 < ntile) {
#pragma unroll
            for (int si = 0; si < 4; ++si) nxt[si] = sp[(size_t)(kt + 1) * 2048 + si * 64]; }
        __builtin_amdgcn_sched_barrier(0);
        const bool last = (kt == ntile - 1);
#pragma unroll
        for (int si = 0; si < 4; ++si) {
            const int key0 = 128 * kt + 16 * (2 * si + kh) + 4 * fq;
            const float s4[4] = {h16f(cur[si].x & 0xffffu), h16f(cur[si].x >> 16), h16f(cur[si].y & 0xffffu), h16f(cur[si].y >> 16)};
            unsigned msel = 0u, mtie = 0u;
#pragma unroll
            for (int r = 0; r < 4; ++r) {
                const float s = s4[r];
                const bool valid = !last || (key0 + r <= tq);
                const bool sel = valid && s >= shi, tie = valid && s >= slo && !(s >= shi);
                msel |= sel ? (1u << r) : 0u; mtie |= tie ? (1u << r) : 0u;
            }
            const int wd = key0 >> 5, sh = key0 & 31;
            if (msel) __hip_atomic_fetch_or((LAS unsigned*)(L + DS_BITS) + qloc * 128 + wd, msel << sh, __ATOMIC_RELAXED, __HIP_MEMORY_SCOPE_WORKGROUP);
            if (mtie) __hip_atomic_fetch_or((LAS unsigned*)(L + DS_TIE) + qloc * 128 + wd, mtie << sh, __ATOMIC_RELAXED, __HIP_MEMORY_SCOPE_WORKGROUP);
        }
#pragma unroll
        for (int si = 0; si < 4; ++si) cur[si] = nxt[si];
    }
    asm volatile("s_waitcnt lgkmcnt(0)" ::: "memory");
    __syncthreads();
}
__device__ __forceinline__ float dsa_thr_score(float inv, float bstarf, bool strict) {
    unsigned lo = 0x03ffu, hi = 0xfc01u;
#pragma unroll 1
    for (int it = 0; it < 16; ++it) { const unsigned mid = (lo + hi) >> 1; const unsigned hb = (mid & 0x8000u) ? (mid & 0x7fffu) : (~mid & 0xffffu);
        const float bf = dsa_binf_inv(inv, h16f(hb)); const bool p = strict ? (bf > bstarf) : (bf >= bstarf);
        if (lo < hi) { if (p) hi = mid; else lo = mid + 1u; } }
    const unsigned hb = (lo & 0x8000u) ? (lo & 0x7fffu) : (~lo & 0xffffu);
    return lo >= 0xfc01u ? __builtin_nanf("") : h16f(hb);
}
__device__ __forceinline__ int wave_incl_scan(int v, int lane) {
    (void)lane;
    v += __builtin_amdgcn_update_dpp(0, v, 0x111, 0xf, 0xf, false);
    v += __builtin_amdgcn_update_dpp(0, v, 0x112, 0xf, 0xf, false);
    v += __builtin_amdgcn_update_dpp(0, v, 0x114, 0xf, 0xf, false);
    v += __builtin_amdgcn_update_dpp(0, v, 0x118, 0xf, 0xf, false);
    v += __builtin_amdgcn_update_dpp(0, v, 0x142, 0xa, 0xf, false);
    v += __builtin_amdgcn_update_dpp(0, v, 0x143, 0xc, 0xf, false);
    return v;
}
#define BITS_ENUM(W0, W1, LANE, TOTAL, BODY) do { \
    const int c_ = __builtin_popcount(W0) + __builtin_popcount(W1); \
    const int p_ = wave_incl_scan(c_, LANE); TOTAL = __builtin_amdgcn_readlane(p_, 63); \
    int pos = p_ - c_; \
    { unsigned w_ = (W0); while (w_) { const int bit_ = __builtin_ctz(w_); w_ &= w_ - 1u; const int key = 64 * (LANE) + bit_; BODY; ++pos; } } \
    { unsigned w_ = (W1); while (w_) { const int bit_ = __builtin_ctz(w_); w_ &= w_ - 1u; const int key = 64 * (LANE) + 32 + bit_; BODY; ++pos; } } } while (0)

__device__ __forceinline__ void dsa_qblock(unsigned char* ws_, int wave_id, int b, int qb, int half, u32x2* sc) {
    extern __shared__ __attribute__((aligned(16))) unsigned char lds_raw[];
    b = __builtin_amdgcn_readfirstlane(b); qb = __builtin_amdgcn_readfirstlane(qb); half = __builtin_amdgcn_readfirstlane(half); asm volatile("" : "+s"(b), "+s"(qb), "+s"(half));
    unsigned char* ws = ws_; MAKE_FRAME();
    LAS unsigned char* L = F.lds;
    const int lane = F.lane, wave = F.wave, tid = F.tid, fr = lane & 15, fq = lane >> 4;
    const bf16_t* proj = (const bf16_t*)(ws + WS_PROJ);
    const bf16_t* pb = proj + (size_t)b * SEQ * NPROJ;
    const bf16_t* kvb = (const bf16_t*)(ws + WS_KVI) + (size_t)b * SEQ * KV_LD;
    bf16_t* mix = (bf16_t*)(ws + WS_MIX);
    {
        const u32x4* kp = (const u32x4*)(kvb + (size_t)(tid >> 2) * KV_LD + KV_IK + 16 * (tid & 3));
        const u32x4 k0 = kp[0], k1 = kp[1]; const unsigned kw[8] = {k0.x, k0.y, k0.z, k0.w, k1.x, k1.y, k1.z, k1.w};
        float sq = 0.f;
#pragma unroll
        for (int j = 0; j < 8; ++j) { const float a = bflo(kw[j]), c = bfhi(kw[j]); sq += a * a + c * c; }
        sq = wave_sum(sq);
        if (lane == 0) ((LAS float*)(L + DS_RED))[wave] = sq;
        const float* lut = (const float*)(ws + WS_TAB + TB_LUT);
        for (int i = tid; i < 1024; i += NWAVES * 64) ((LAS float*)(L + DS_LUT))[i] = 8.0f * lut[i];
        for (int i = tid; i < 16384; i += NWAVES * 64) ((LAS unsigned*)(L + DS_HIST))[i] = 0u;
        for (int i = tid; i < 8192; i += NWAVES * 64) ((LAS unsigned*)(L + DS_BITS))[i] = 0u;
    }
    __syncthreads();
    float krms;
    { const LAS float* rp = (const LAS float*)(L + DS_RED); krms = sqrtf((((rp[0] + rp[1]) + (rp[2] + rp[3])) + ((rp[4] + rp[5]) + (rp[6] + rp[7]))) * (1.0f / 8192.0f)); }
    float qinv;
    {
        const int qg = wave & 3; const int tq = 64 * qb + 16 * qg + fr;
        DsaQ Q; dsa_build_q(Q, pb, kvb, (size_t)tq, fq, krms);
        dsa_pass<1>(L, kvb + KV_IK, qb, wave, lane, Q, tq, 0, sc);
        qinv = Q.inv;
    }
    for (int qi = 0; qi < 8; ++qi) {
        const int q = 8 * wave + qi, t = 64 * qb + q, n = t + 1;
        int bst = -1, rr = 0, nst = 0;
        if (n > TOPK) {
            const LAS unsigned* hp = (const LAS unsigned*)(L + DS_HIST) + q * 256;
            int c[4]; int s4 = 0;
#pragma unroll
            for (int j = 0; j < 4; ++j) { c[j] = (int)hp[4 * lane + j]; s4 += c[j]; }
            int x = s4;
#pragma unroll
            for (int o = 1; o < 64; o <<= 1) { const int y = bperm_i(x, lane + o); if (lane + o < 64) x += y; }
            int cum = x - s4; int fb = -1, fc = 0, fn = 0;
#pragma unroll
            for (int j = 3; j >= 0; --j) { if (cum < TOPK && TOPK <= cum + c[j]) { fb = 4 * lane + j; fc = cum; fn = c[j]; } cum += c[j]; }
            const unsigned long long m = __ballot(fb >= 0);
            const int src = m ? (int)__builtin_ctzll(m) : 0;
            bst = __builtin_amdgcn_readlane(fb, src); rr = TOPK - __builtin_amdgcn_readlane(fc, src); nst = __builtin_amdgcn_readlane(fn, src);
        }
        if (lane == 0) { LAS int* tp = (LAS int*)(L + DS_THR) + 4 * q; tp[0] = bst; tp[1] = rr; tp[2] = nst; tp[3] = 0; }
    }
    __syncthreads();
    for (int i = tid; i < 8192; i += NWAVES * 64) ((LAS unsigned*)(L + DS_TIE))[i] = 0u;
    __syncthreads();
    {
        const int qg = wave & 3; const int tq = 64 * qb + 16 * qg + fr;
        const int bstar = ((const LAS int*)(L + DS_THR))[4 * (16 * qg + fr)];
        const float bstarf = (float)(bstar - 128);
        const float shi = dsa_thr_score(qinv, bstarf, true), slo = dsa_thr_score(qinv, bstarf, false);
        dsa_pass2s(L, sc, qb, wave, lane, tq, shi, slo);
    }
    LAS unsigned char* WM = L + DS_WMISC + wave * 1024;
    LAS unsigned short* LIST = (LAS unsigned short*)(WM + DW_LIST);
    LAS unsigned* SCR = (LAS unsigned*)(WM + DW_SCR);
#pragma unroll 1
    for (int qi = (half == 1 ? 4 : 0); qi < (half == 0 ? 4 : 8); ++qi) {
        const int q = 8 * wave + qi, qcol = q & 15;
        const LAS int* tp = (const LAS int*)(L + DS_THR) + 4 * q;
        const int bst = tp[0], rr = tp[1], nst = tp[2];
        if (rr > 0 && rr < nst && bst != 128 && nst <= 64) {
            const LAS unsigned* TW = (const LAS unsigned*)(L + DS_TIE) + q * 128;
            const unsigned tw0 = TW[2 * lane], tw1 = TW[2 * lane + 1];
            LAS unsigned short* IDXR = (LAS unsigned short*)(L + DS_CAND + q * 512 + 256);
            { int tot_; BITS_ENUM(tw0, tw1, lane, tot_, { if (pos < 64) IDXR[pos] = (unsigned short)key; }); (void)tot_; }
            asm volatile("s_waitcnt lgkmcnt(0)" ::: "memory");
            const int ky = lane < nst ? (int)IDXR[lane] : 0, sb = (ky >> 4) & 7;
            const unsigned* dp = (const unsigned*)(sc + (size_t)((((ky >> 7) * 8 + (sb & 1) * 4 + (q >> 4)) * 4 + (sb >> 1)) * 64 + ((ky >> 2) & 3) * 16 + qcol)) + ((ky >> 1) & 1);
            glds4(dp, (unsigned)__builtin_amdgcn_readfirstlane((int)(unsigned)(size_t)(L + DS_CAND + q * 512)));
        }
    }
    asm volatile("s_waitcnt vmcnt(0)" ::: "memory");
#pragma unroll 1
    for (int qi = (half == 1 ? 4 : 0); qi < (half == 0 ? 4 : 8); ++qi) {
        const int q = 8 * wave + qi, t = 64 * qb + q, n = t + 1, qcol = q & 15;
        const LAS int* tp = (const LAS int*)(L + DS_THR) + 4 * q;
        const int bst = tp[0], rr = tp[1], nst = tp[2];
        LAS unsigned* BW = (LAS unsigned*)(L + DS_BITS) + q * 128;
        const LAS unsigned* TW = (const LAS unsigned*)(L + DS_TIE) + q * 128;
        if (rr > 0) {
            const unsigned tw0 = TW[2 * lane], tw1 = TW[2 * lane + 1];
            const int ZBq = 128;
            if (rr >= nst) { BW[2 * lane] |= tw0; BW[2 * lane + 1] |= tw1; }
            else if (bst == ZBq) {
                int tot; BITS_ENUM(tw0, tw1, lane, tot, { if (pos < rr) __hip_atomic_fetch_or(BW + (key >> 5), 1u << (key & 31), __ATOMIC_RELAXED, __HIP_MEMORY_SCOPE_WORKGROUP); });
                (void)tot;
            } else {
                const int nb = (nst + 63) >> 6;
                unsigned k0 = 0u; int idx0 = 0;
#define TIE_BATCH(bt_, KOUT, IOUT) do { \
                    { int tot_; BITS_ENUM(tw0, tw1, lane, tot_, { const int pp_ = pos - 64 * (bt_); if (pp_ >= 0 && pp_ < 64) LIST[pp_] = (unsigned short)key; }); (void)tot_; } \
                    asm volatile("s_waitcnt lgkmcnt(0)" ::: "memory"); \
                    const int rem_ = nst - 64 * (bt_); const bool v_ = lane < rem_; IOUT = v_ ? (int)LIST[lane] : 0; \
                      \
                    const int ky_ = IOUT, sb_ = (ky_ >> 4) & 7; \
                    const unsigned short* sp_ = (const unsigned short*)(sc + (size_t)((((ky_ >> 7) * 8 + (sb_ & 1) * 4 + (q >> 4)) * 4 + (sb_ >> 1)) * 64 + ((ky_ >> 2) & 3) * 16 + qcol)) + (ky_ & 3); \
                    KOUT = v_ ? fkey(h16f((unsigned)*sp_)) : 0u; } while (0)
                const int tmode = nb == 1 ? 0 : (nst <= 512 ? 1 : 2);
                LAS u32x2* KE = (LAS u32x2*)(L + wave * 4096);
                if (tmode == 0) {
                    { const LAS unsigned* SCRW = (const LAS unsigned*)(L + DS_CAND + q * 512); const LAS unsigned short* IDXR = (const LAS unsigned short*)(L + DS_CAND + q * 512 + 256);
                      const bool v_ = lane < nst; idx0 = v_ ? (int)IDXR[lane] : 0; const unsigned dw_ = SCRW[lane];
                      const unsigned hb_ = (idx0 & 1) ? (dw_ >> 16) : (dw_ & 0xffffu);
                      k0 = v_ ? ((hb_ & 0x8000u) ? (~hb_ & 0xffffu) : (hb_ | 0x8000u)) : 0u; }
                    unsigned T = 0u;
                    for (int bit = 15; bit >= 0; --bit) { const unsigned cand = T | (1u << bit); if ((int)__builtin_popcountll(__ballot(k0 >= cand)) >= rr) T = cand; }
                    const int cgt = (int)__builtin_popcountll(__ballot(k0 > T));
                    const unsigned long long be = __ballot(k0 == T && lane < nst);
                    const unsigned long long lt = (lane == 0) ? 0ull : (~0ull >> (64 - lane));
                    const bool take = (k0 > T) || (k0 == T && lane < nst && (int)__builtin_popcountll(be & lt) < rr - cgt);
                    if (take) __hip_atomic_fetch_or(BW + (idx0 >> 5), 1u << (idx0 & 31), __ATOMIC_RELAXED, __HIP_MEMORY_SCOPE_WORKGROUP);
                } else {
                if (tmode == 1) { for (int bt = 0; bt < nb; ++bt) { unsigned kk; int ii; TIE_BATCH(bt, kk, ii); if (lane < nst - 64 * bt) { u32x2 e; e.x = kk; e.y = (unsigned)ii; KE[64 * bt + lane] = e; } }
                    asm volatile("s_waitcnt lgkmcnt(0)" ::: "memory"); }
#define TIE_GET(bt_, KOUT, IOUT) do { if (tmode == 0) { KOUT = k0; IOUT = idx0; } else if (tmode == 1) { const bool vv_ = lane < nst - 64 * (bt_); const u32x2 e_ = KE[vv_ ? 64 * (bt_) + lane : 0]; KOUT = vv_ ? e_.x : 0u; IOUT = vv_ ? (int)e_.y : 0; } \
                    else TIE_BATCH(bt_, KOUT, IOUT); } while (0)
                unsigned T = 0u;
                for (int bit = 31; bit >= 0; --bit) {
                    const unsigned cand = T | (1u << bit); int cnt = 0;
                    for (int bt = 0; bt < nb; ++bt) { unsigned kk; int ii; TIE_GET(bt, kk, ii); (void)ii; cnt += __builtin_popcountll(__ballot(lane < nst - 64 * bt && kk >= cand)); }
                    if (cnt >= rr) T = cand;
                }
                int cgt = 0;
                for (int bt = 0; bt < nb; ++bt) { unsigned kk; int ii; TIE_GET(bt, kk, ii); (void)ii; cgt += __builtin_popcountll(__ballot(lane < nst - 64 * bt && kk > T)); }
                int eqleft = rr - cgt;
                const unsigned long long lt = (lane == 0) ? 0ull : (~0ull >> (64 - lane));
                for (int bt = 0; bt < nb; ++bt) {
                    unsigned kk; int ii; TIE_GET(bt, kk, ii);
                    const bool v = lane < nst - 64 * bt; const bool pg = v && kk > T, pe = v && kk == T;
                    const unsigned long long be = __ballot(pe);
                    int eqrank = (int)__builtin_popcountll(be & lt);
                    if (tmode == 0) { eqrank = 0; unsigned long long m_ = be;
                        while (m_) { const int j_ = (int)__builtin_ctzll(m_); m_ &= m_ - 1ull; const int ij_ = __builtin_amdgcn_readlane(ii, j_); eqrank += (pe && ij_ < ii) ? 1 : 0; } }
                    const bool take = pg || (pe && eqrank < eqleft);
                    if (take) __hip_atomic_fetch_or(BW + (ii >> 5), 1u << (ii & 31), __ATOMIC_RELAXED, __HIP_MEMORY_SCOPE_WORKGROUP);
                    eqleft -= (int)__builtin_popcountll(be); eqleft = eqleft < 0 ? 0 : eqleft;
                }
                }
#undef TIE_GET
#undef TIE_BATCH
            }
            asm volatile("s_waitcnt lgkmcnt(0)" ::: "memory");
        }
        int nsel;
        LAS unsigned short* LQ = (LAS unsigned short*)(L + DS_TIE) + q * 256;
        { const unsigned bw0 = BW[2 * lane], bw1 = BW[2 * lane + 1];
          asm volatile("s_waitcnt lgkmcnt(0)" ::: "memory");
          BITS_ENUM(bw0, bw1, lane, nsel, { if (pos < TOPK) LQ[pos] = (unsigned short)key; }); }
        nsel = nsel > TOPK ? TOPK : nsel;
        for (int i = nsel + lane; i < TOPK; i += 64) LQ[i] = 0;
        asm volatile("s_waitcnt lgkmcnt(0)" ::: "memory");
    }
    {
        const int qlo = (half == 1 ? 4 : 0), nq = (half == 2 ? 8 : 4), nstep = 4 * nq;
        LAS unsigned char* vb = L + wave * 4096;
        bf16x8 kA[4][2], kB[4][2]; u32x4 vA[2][4], vB[2][4]; bf16x8 qfA[2], qfB[2];
        const bf16x8 zf = {0, 0, 0, 0, 0, 0, 0, 0};
        float m_run = -1e30f, l_run = 0.f; f32x4 oacc[4];
        const float bfar = ((const LAS float*)(L + DS_LUT))[127 * 8 + (fr & 7)];
#pragma unroll
        for (int dt = 0; dt < 4; ++dt) oacc[dt] = (f32x4){0.f, 0.f, 0.f, 0.f};
#define AT_LOAD(kX, vX, s_) do { const int q_ = 8 * wave + qlo + ((s_) >> 2), g_ = (s_) & 3; const LAS unsigned short* LQ_ = (const LAS unsigned short*)(L + DS_TIE) + q_ * 256 + 64 * g_; \
            _Pragma("unroll") for (int tt = 0; tt < 4; ++tt) { const int sk_ = LQ_[16 * tt + fr]; const bf16_t* kr_ = kvb + (size_t)sk_ * KV_LD + KV_DK + 8 * fq; kX[tt][0] = *(const bf16x8*)kr_; kX[tt][1] = *(const bf16x8*)(kr_ + 32); } \
            _Pragma("unroll") for (int st = 0; st < 2; ++st) _Pragma("unroll") for (int i4 = 0; i4 < 4; ++i4) { const int sv_ = LQ_[32 * st + 8 * i4 + (lane >> 3)]; vX[st][i4] = *(const u32x4*)(kvb + (size_t)sv_ * KV_LD + KV_DV + 8 * (lane & 7)); } } while (0)
#define AT_LOADQ(qfX, s_) do { const int q_ = 8 * wave + qlo + ((s_) >> 2); const bf16_t* qp_ = proj + ((size_t)b * SEQ + 64 * qb + q_) * NPROJ + PC_DQ + (fr & 7) * 64 + 8 * fq; \
            qfX[0] = fr < 8 ? *(const bf16x8*)qp_ : zf; qfX[1] = fr < 8 ? *(const bf16x8*)(qp_ + 32) : zf; } while (0)
#define AT_COMPUTE(kX, vX, qfX, s_) do { const int q_ = 8 * wave + qlo + ((s_) >> 2), g_ = (s_) & 3, t_ = 64 * qb + q_; const int nsel_ = (t_ + 1) > TOPK ? TOPK : (t_ + 1); \
            const LAS unsigned short* LQ_ = (const LAS unsigned short*)(L + DS_TIE) + q_ * 256 + 64 * g_; \
            if (g_ == 0) { m_run = -1e30f; l_run = 0.f; _Pragma("unroll") for (int dt = 0; dt < 4; ++dt) oacc[dt] = (f32x4){0.f, 0.f, 0.f, 0.f}; } \
            f32x4 lg_[4]; \
              \
            const int far_ = __builtin_amdgcn_readfirstlane((nsel_ == TOPK && t_ - (int)LQ_[63] >= 127) ? 1 : 0); \
            if (far_) { _Pragma("unroll") for (int tt = 0; tt < 4; ++tt) lg_[tt] = (f32x4){bfar, bfar, bfar, bfar}; } \
            else { _Pragma("unroll") for (int tt = 0; tt < 4; ++tt) { const u32x2 sv_ = *(const LAS u32x2*)(LQ_ + 16 * tt + 4 * fq); \
                const int s4_[4] = {(int)(sv_.x & 0xffffu), (int)(sv_.x >> 16), (int)(sv_.y & 0xffffu), (int)(sv_.y >> 16)}; f32x4 bz_; \
                _Pragma("unroll") for (int r = 0; r < 4; ++r) { int d_ = t_ - s4_[r]; d_ = d_ > 127 ? 127 : d_; \
                    bz_[r] = ((const LAS float*)(L + DS_LUT))[d_ * 8 + (fr & 7)]; } \
                if (nsel_ < TOPK) { _Pragma("unroll") for (int r = 0; r < 4; ++r) bz_[r] = (64 * g_ + 16 * tt + 4 * fq + r < nsel_) ? bz_[r] : -8e30f; }      \
                lg_[tt] = bz_; } } \
            _Pragma("unroll") for (int tt = 0; tt < 4; ++tt) { lg_[tt] = __builtin_amdgcn_mfma_f32_16x16x32_bf16(kX[tt][0], qfX[0], lg_[tt], 0, 0, 0); lg_[tt] = __builtin_amdgcn_mfma_f32_16x16x32_bf16(kX[tt][1], qfX[1], lg_[tt], 0, 0, 0); } \
            float gm_ = fmaxf(fmaxf(fmaxf(lg_[0][0], lg_[0][1]), fmaxf(lg_[0][2], lg_[0][3])), fmaxf(fmaxf(lg_[1][0], lg_[1][1]), fmaxf(lg_[1][2], lg_[1][3]))); \
            gm_ = fmaxf(gm_, fmaxf(fmaxf(fmaxf(lg_[2][0], lg_[2][1]), fmaxf(lg_[2][2], lg_[2][3])), fmaxf(fmaxf(lg_[3][0], lg_[3][1]), fmaxf(lg_[3][2], lg_[3][3])))); \
              \
            gm_ = xq_max(gm_); const float mn_ = fmaxf(m_run, gm_); const float al_ = __builtin_amdgcn_exp2f((m_run - mn_) * 0.18033688f); m_run = mn_; float ps_ = 0.f; const float nmc_ = -mn_ * 0.18033688f; \
            _Pragma("unroll") for (int tt = 0; tt < 4; ++tt) _Pragma("unroll") for (int r = 0; r < 4; ++r) { const float e_ = __builtin_amdgcn_exp2f(__builtin_fmaf(lg_[tt][r], 0.18033688f, nmc_)); lg_[tt][r] = e_; ps_ += e_; } \
            ps_ = xq_sum(ps_); l_run = l_run * al_ + ps_; \
            if (__builtin_amdgcn_ballot_w64(al_ != 1.0f) != 0ull) { _Pragma("unroll") for (int dt = 0; dt < 4; ++dt) oacc[dt] = oacc[dt] * al_; }     \
            _Pragma("unroll") for (int st = 0; st < 2; ++st) { \
                _Pragma("unroll") for (int i4 = 0; i4 < 4; ++i4) { const int row_ = 8 * i4 + (lane >> 3); *(LAS u32x4*)(vb + swzB(row_, 16 * (lane & 7))) = vX[st][i4]; } \
                u32x4 pw_; pw_.x = pg8::cvt_pk_bf16(lg_[2 * st][0], lg_[2 * st][1]); pw_.y = pg8::cvt_pk_bf16(lg_[2 * st][2], lg_[2 * st][3]); pw_.z = pg8::cvt_pk_bf16(lg_[2 * st + 1][0], lg_[2 * st + 1][1]); pw_.w = pg8::cvt_pk_bf16(lg_[2 * st + 1][2], lg_[2 * st + 1][3]); \
                const bf16x8 pbv_ = __builtin_bit_cast(bf16x8, pw_); \
                _Pragma("unroll") for (int dt = 0; dt < 4; ++dt) { \
                    const s16x4 v0_ = tr_rd(vb + swzB(4 * fq + (fr >> 2), 32 * dt + 8 * (fr & 3))), v1_ = tr_rd(vb + swzB(16 + 4 * fq + (fr >> 2), 32 * dt + 8 * (fr & 3))); \
                    const bf16x8 va_ = __builtin_shufflevector(v0_, v1_, 0, 1, 2, 3, 4, 5, 6, 7); \
                    oacc[dt] = __builtin_amdgcn_mfma_f32_16x16x32_bf16(va_, pbv_, oacc[dt], 0, 0, 0); } \
                asm volatile("" ::: "memory"); } \
            if (g_ == 3) { const float ri_ = 1.0f / l_run; const size_t tok_ = (size_t)b * SEQ + t_; \
                if (fr < 8) { _Pragma("unroll") for (int dt = 0; dt < 4; ++dt) { u32x2 ow_; ow_.x = pg8::cvt_pk_bf16(oacc[dt][0] * ri_, oacc[dt][1] * ri_); ow_.y = pg8::cvt_pk_bf16(oacc[dt][2] * ri_, oacc[dt][3] * ri_); \
                    *(u32x2*)(mix + tok_ * 1024 + 256 + fr * 64 + 16 * dt + 4 * fq) = ow_; } } } } while (0)
#define SB() __builtin_amdgcn_sched_barrier(0)
        AT_LOADQ(qfA, 0); AT_LOAD(kA, vA, 0); SB();
#pragma unroll 1
        for (int s2 = 0; s2 < nstep; s2 += 2) {
            AT_LOAD(kB, vB, s2 + 1); SB();
            AT_COMPUTE(kA, vA, qfA, s2); SB();
            if (s2 + 2 < nstep) { if (((s2 + 2) & 3) == 0) AT_LOADQ(qfB, s2 + 2); AT_LOAD(kA, vA, s2 + 2); } SB();
            AT_COMPUTE(kB, vB, qfA, s2 + 1); SB();
            if (((s2 + 2) & 3) == 0) { qfA[0] = qfB[0]; qfA[1] = qfB[1]; }
        }
#undef AT_LOAD
#undef AT_LOADQ
#undef AT_COMPUTE
    }
    asm volatile("s_waitcnt lgkmcnt(0)" ::: "memory");
    __syncthreads();
}

__global__ void __launch_bounds__(NWAVES * 64, 2) trunk_fwd(Args args) {
    extern __shared__ __attribute__((aligned(16))) unsigned char lds_raw[];
    unsigned* ctl = (unsigned*)(args.ws + WS_CTL);
    const int wave_id = __builtin_amdgcn_readfirstlane(threadIdx.x >> 6);
    volatile LAS unsigned* MISC = (volatile LAS unsigned*)((LAS unsigned char*)lds_raw + MISC_OFF);
    if (wave_id == 0) MISC[lane_id()] = 0u;
    __syncthreads();
    XcdBarrier bar = xcd_barrier_post(ctl + CW_BAR, MISC + 8, wave_id == 0 && lane_id() == 0);
#define GRID_BAR() do { XcdBarrier bb_ = bar; asm volatile("" : "+s"(bb_.bar)); asm volatile("" : "+s"(bb_.x)); xcd_barrier(bb_, wave_id == 0 && lane_id() == 0); } while (0)
#define PHASE_PTRS() size_t z_ = 0; asm volatile("" : "+s"(z_)); unsigned char* ws = args.ws + z_;     \
    bf16_t* WIN = (bf16_t*)(ws + WS_WIN); bf16_t* WOUT = (bf16_t*)(ws + WS_WOUT); bf16_t* WFFI = (bf16_t*)(ws + WS_WFFI); bf16_t* WFFO = (bf16_t*)(ws + WS_WFFO); \
    bf16_t* XB = (bf16_t*)(ws + WS_XB); float* SS = (float*)(ws + WS_SS); bf16_t* PROJ = (bf16_t*)(ws + WS_PROJ); bf16_t* MIX = (bf16_t*)(ws + WS_MIX); bf16_t* HID = (bf16_t*)(ws + WS_HID); \
    bf16_t* YG = (bf16_t*)(ws + WS_YG); float* tabf = (float*)(ws + WS_TAB); \
    (void)WIN; (void)WOUT; (void)WFFI; (void)WFFO; (void)XB; (void)SS; (void)PROJ; (void)MIX; (void)HID; (void)YG; (void)tabf; MAKE_FRAME();
#define LAYER_IDX() int l = l_; asm volatile("" : "+s"(l));
    {
        PHASE_PTRS();
        LAS float* scr = (LAS float*)(F.lds + F.wave * 16384);
        constexpr int I_IN = 16 * (NPROJ / 32), I_OUT = 16 * 32, I_FFI = 16 * (2 * D_FF / 32), I_FFO = (D_FF / 64) * 32, I_L = I_IN + I_OUT + I_FFI + I_FFO;
        for (int it = F.gw; it < DEPTH * I_L; it += F.NGW) {
            const int l = it / I_L; int r = it % I_L;
            if (r < I_IN) { transpose_item<1>(args.in[1] + (size_t)l * D_MODEL * IN_W, D_MODEL, IN_W, NPROJ, args.in[3] + l * D_MODEL, WIN + (size_t)l * NPROJ * D_MODEL, scr, r, F.lane); continue; } r -= I_IN;
            if (r < I_OUT) { transpose_item<0>(args.in[2] + (size_t)l * 1024 * 1024, 1024, 1024, 1024, nullptr, WOUT + (size_t)l * 1024 * 1024, scr, r, F.lane); continue; } r -= I_OUT;
            if (r < I_FFI) { transpose_item<2>(args.in[17] + (size_t)l * D_MODEL * 2 * D_FF, D_MODEL, 2 * D_FF, 2 * D_FF, args.in[16] + l * D_MODEL, WFFI + (size_t)l * 2 * D_FF * D_MODEL, scr, r, F.lane); continue; } r -= I_FFI;
            transpose_item<0, true>(args.in[18] + (size_t)l * D_FF * D_MODEL, D_FF, D_MODEL, D_MODEL, nullptr, (bf16_t*)((unsigned char*)WFFO + (size_t)l * D_MODEL * D_FF), scr, r, F.lane);
        }
        for (int it = F.gw; it < DEPTH * 32; it += F.NGW) { const int l = it >> 5;
            transpose_item<0>(args.in[12] + (size_t)l * 65536, 256, 256, 256, nullptr, (bf16_t*)(ws + WS_GLUT) + (size_t)l * 65536, scr, it & 31, F.lane); }
        for (int m = F.gw; m < MTOK; m += F.NGW) {
            const f32x4* xr = (const f32x4*)(args.in[0] + (size_t)m * D_MODEL) + F.lane;
            f32x4 v[4]; float s = 0.f;
#pragma unroll
            for (int j = 0; j < 4; ++j) { v[j] = xr[64 * j]; s += (v[j][0] * v[j][0] + v[j][1] * v[j][1]) + (v[j][2] * v[j][2] + v[j][3] * v[j][3]); }
            s = wave_sum(s);
            u32x2* o8 = (u32x2*)(XB + (size_t)m * D_MODEL) + F.lane;
#pragma unroll
            for (int j = 0; j < 4; ++j) { u32x2 w; w.x = pk2(v[j][0], v[j][1]); w.y = pk2(v[j][2], v[j][3]); o8[64 * j] = w; }
            if (F.lane < 16) SS[(size_t)m * 16 + F.lane] = (F.lane == 0) ? s : 0.f;
        }
        const int gt = blockIdx.x * (NWAVES * 64) + F.tid, NT = F.G * NWAVES * 64;
        for (int i = gt; i < SEQ * 32; i += NT) { const int pos = i >> 5, fi = i & 31;
            const float inv = powf(10000.0f, -(float)fi / 32.0f); const float ang = (float)pos * inv;
            tabf[TB_ROPE / 4 + (size_t)i * 2] = cosf(ang); tabf[TB_ROPE / 4 + (size_t)i * 2 + 1] = sinf(ang); }
        for (int i = gt; i < 128 * 8; i += NT) { const int dist = i >> 3, hh = i & 7;
            int bk; if (dist < 16) bk = dist; else { bk = 16 + (int)(logf((float)dist / 16.0f) / 2.0794415416798357f * 16.0f); bk = bk > 31 ? 31 : bk; }
            tabf[TB_LUT / 4 + i] = args.in[14][bk * 8 + hh]; }
#define S5_DISC(i__) const int l = (i__) / (S5_G * S5_N), g = ((i__) / S5_N) % S5_G, n = (i__) % S5_N; \
            const float ar = args.in[4][(i__)], ai = args.in[5][(i__)]; const float dt = expf(args.in[6][l * S5_G + g]); \
            const float mag = expf(ar * dt), ang = ai * dt; const float abr = mag * cosf(ang), abi = mag * sinf(ang); \
            const float den = ar * ar + ai * ai, nr = abr - 1.0f, ni = abi; \
            const float cr = (nr * ar + ni * ai) / den, ci = (ni * ar - nr * ai) / den; (void)l; (void)g; (void)n; (void)cr; (void)ci;
        if (F.tid < 16) for (int i = (int)blockIdx.x * 16 + F.tid; i < DEPTH * S5_G * S5_N; i += F.G * 16) { S5_DISC(i)
            tabf[TB_S5AB / 4 + (size_t)i * 2] = abr; tabf[TB_S5AB / 4 + (size_t)i * 2 + 1] = abi;
            float pr = 1.f, pi = 0.f; float* pw = tabf + TB_POW / 4 + (size_t)i * 130;
            for (int d = 0; d <= 64; ++d) { pw[2 * d] = pr; pw[2 * d + 1] = pi; const float nr2 = pr * abr - pi * abi, ni2 = pr * abi + pi * abr; pr = nr2; pi = ni2; } }
        for (int j = gt; j < DEPTH * S5_G * S5_N * 16; j += NT) { const int i = j >> 4, q = j & 15; S5_DISC(i)
            const float br = args.in[7][(size_t)i * 16 + q], bi = args.in[8][(size_t)i * 16 + q];
            tabf[TB_S5BB / 4 + (size_t)i * 32 + 2 * q] = cr * br - ci * bi; tabf[TB_S5BB / 4 + (size_t)i * 32 + 2 * q + 1] = cr * bi + ci * br;
            const size_t cidx = ((size_t)(l * S5_G + g) * S5_P + q) * S5_N + n;
            tabf[TB_S5C / 4 + (size_t)i * 32 + 2 * q] = args.in[9][cidx]; tabf[TB_S5C / 4 + (size_t)i * 32 + 2 * q + 1] = args.in[10][cidx]; }
#undef S5_DISC
    }
    GRID_BAR();
    {
        PHASE_PTRS();
        LAS float* pl = (LAS float*)F.lds;
        for (int u = (int)blockIdx.x; u < DEPTH * S5_G * 4; u += F.G) {
            const int lg = u >> 2, dq = u & 3;
            const float* POW = tabf + TB_POW / 4 + (size_t)lg * S5_N * 130; const float* BB = tabf + TB_S5BB / 4 + (size_t)lg * S5_N * 32; const float* CC = tabf + TB_S5C / 4 + (size_t)lg * S5_N * 32;
            __syncthreads();
            for (int i = F.tid; i < 2048; i += NWAVES * 64) { const int n = i >> 5, r = i & 31; pl[i] = POW[n * 130 + 32 * dq + r]; pl[2048 + i] = CC[i]; pl[4096 + i] = BB[i]; }
            __syncthreads();
            const int pq = F.tid & 255, p = pq >> 4, q = pq & 15, dh = F.wave >> 2;
            float acc[8];
#pragma unroll
            for (int d = 0; d < 8; ++d) acc[d] = 0.f;
#pragma unroll
            for (int n0 = 0; n0 < 64; n0 += 16) {
                float wr[16], wi[16];
#pragma unroll
                for (int k = 0; k < 16; ++k) { const int n = n0 + k; const float cr = pl[2048 + n * 32 + 2 * p], ci = pl[2048 + n * 32 + 2 * p + 1], br = pl[4096 + n * 32 + 2 * q], bi = pl[4096 + n * 32 + 2 * q + 1];
                    wr[k] = cr * br - ci * bi; wi[k] = cr * bi + ci * br; }
#pragma unroll
                for (int d = 0; d < 8; ++d) { const int dd = 8 * dh + d; float s0 = 0.f, s1 = 0.f;
#pragma unroll
                    for (int k = 0; k < 16; k += 2) { const int n = n0 + k; const float pr0 = pl[n * 32 + 2 * dd], pi0 = pl[n * 32 + 2 * dd + 1], pr1 = pl[n * 32 + 32 + 2 * dd], pi1 = pl[n * 32 + 32 + 2 * dd + 1];
                        s0 += wr[k] * pr0 - wi[k] * pi0; s1 += wr[k + 1] * pr1 - wi[k + 1] * pi1; }
                    acc[d] += s0 + s1; }
            }
#pragma unroll
            for (int d = 0; d < 8; ++d) tabf[TB_KC / 4 + ((size_t)(lg * 64 + 16 * dq + 8 * dh + d)) * 256 + pq] = acc[d];
        }
        __syncthreads();
    }
    GRID_BAR();

    for (int l_ = 0; l_ < DEPTH; ++l_) {
        {
            PHASE_PTRS(); LAYER_IDX();
            pg8::Gemm g{XB, WIN + (size_t)l * NPROJ * D_MODEL, D_MODEL, D_MODEL, D_MODEL}; pg8::StaticOrder S; S.init(MTOK, NPROJ, F.G, (int)blockIdx.x);
            s5_expand(F, args, l);
            LAS float* rs_tab = (LAS float*)(F.lds + RING_BYTES);
            { pg8::Unit u_; for (int i = 0; S.next(i, u_); ++i) if (F.tid < 256) rs_tab[i * 256 + F.tid] = pg8::row_rstd(SS, u_.pm * 256 + F.tid); }
            __syncthreads();
            pg8::EpiProj E{PROJ, NPROJ, rs_tab, (bf16_t*)(ws + WS_S5U), (bf16_t*)(ws + WS_KVI)};
            pg8::gemm_phase<pg8::EpiProj, pg8::StaticOrder, true, true>(F.lds, g, S, E, F.wave);
        }
        GRID_BAR();
        {
            PHASE_PTRS(); LAYER_IDX();
            unsigned* wkb = ctl + CW_WORK + 64 * 8 * l;
            if (wave_id == 0 && lane_id() == 0) MISC[17] = 0u;
            for (;;) {
                __syncthreads();
                if (wave_id == 0 && lane_id() == 0) {
                    unsigned it = 0xffffffffu; const int myq = (int)(xb_xcc_id() & 7u); int qoff = (int)MISC[17];
                    for (; qoff < 8; ++qoff) { const int q = (myq + qoff) & 7; const unsigned i = __hip_atomic_fetch_add(wkb + 64 * q, 1u, __ATOMIC_RELAXED, __HIP_MEMORY_SCOPE_AGENT); if (i < 88u) { it = (unsigned)q * 256u + i; break; } }
                    MISC[16] = it; MISC[17] = (unsigned)qoff;
                }
                __syncthreads();
                const unsigned it = (unsigned)__builtin_amdgcn_readfirstlane((int)MISC[16]);
                if (it == 0xffffffffu) break;
                const int q = (int)(it >> 8), i = (int)(it & 255u);
                if (i >= 4 && i < 8) ret_unit(ws, wave_id, args.in[15], l, q, i - 4);
                else if (i < 4) { const int u = q * 4 + i; s5_unit(ws, wave_id, l, u >> 1, u & 1); }
                else { u32x2* sc = (u32x2*)((unsigned char*)args.out + z_) + (size_t)blockIdx.x * 65536;
                    if (i < 56) dsa_qblock(ws, wave_id, q, 63 - (i - 8), 2, sc);
                    else dsa_qblock(ws, wave_id, q, 15 - ((i - 56) >> 1), (i - 56) & 1, sc); }
            }
        }
        GRID_BAR();
        {
            PHASE_PTRS(); LAYER_IDX();
            pg8::Gemm g{(const bf16_t*)YG, (const bf16_t*)(ws + WS_GLUT) + (size_t)l * 65536, 256, 256, 256}; pg8::StaticOrder S; S.init(MTOK, 256, F.G, (int)blockIdx.x);
            pg8::EpiGLU E{(const bf16_t*)YG, MIX, args.in[13] + (size_t)l * 256};
            pg8::gemm_phase<pg8::EpiGLU, pg8::StaticOrder, true, true>(F.lds, g, S, E, F.wave);
        }
        GRID_BAR();
        {
            PHASE_PTRS(); LAYER_IDX();
            pg8::Gemm g{MIX, WOUT + (size_t)l * 1024 * 1024, 1024, 1024, 1024}; pg8::StaticOrder S; S.init(MTOK, D_MODEL, F.G, (int)blockIdx.x);
            pg8::EpiResidB E{XB, SS, 1.0f};
            pg8::gemm_phase<pg8::EpiResidB, pg8::StaticOrder, true, true>(F.lds, g, S, E, F.wave);
        }
        GRID_BAR();
        {
            PHASE_PTRS(); LAYER_IDX();
            pg8::Gemm g{XB, WFFI + (size_t)l * 2 * D_FF * D_MODEL, D_MODEL, D_MODEL, D_MODEL}; pg8::StaticOrder S; S.init(MTOK, 2 * D_FF, F.G, (int)blockIdx.x);
            LAS float* rs_tab = (LAS float*)(F.lds + RING_BYTES);
            { pg8::Unit u_; for (int i = 0; S.next(i, u_); ++i) if (F.tid < 256) rs_tab[i * 256 + F.tid] = pg8::row_rstd(SS, u_.pm * 256 + F.tid); }
            __syncthreads();
            pg8::EpiSwiGLU8 E{(unsigned char*)HID, D_FF, rs_tab};
            pg8::gemm_phase<pg8::EpiSwiGLU8, pg8::StaticOrder, true, true>(F.lds, g, S, E, F.wave);
        }
        GRID_BAR();
        {
            PHASE_PTRS(); LAYER_IDX();
            pg8::Gemm g{HID, (const bf16_t*)((const unsigned char*)WFFO + (size_t)l * D_MODEL * D_FF), D_FF / 2, D_FF / 2, D_FF / 2}; pg8::StaticOrder S; S.init(MTOK, D_MODEL, F.G, (int)blockIdx.x);
            pg8::EpiResidB E{XB, SS, 1.0f / (F8_WS * F8_HS)};
            pg8::gemm_phase<pg8::EpiResidB, pg8::StaticOrder, true, true, 0, true>(F.lds, g, S, E, F.wave);
        }
        GRID_BAR();
    }
    {
        PHASE_PTRS();
        const unsigned tmo = __hip_atomic_load(ctl + CW_BAR + XB_TMO, __ATOMIC_RELAXED, __HIP_MEMORY_SCOPE_AGENT);
        const float* gf = args.in[19];
        for (int m = F.gw; m < MTOK; m += F.NGW) {
            float rs = pg8::row_rstd(SS, m);
            if (tmo) rs = __builtin_nanf("");
            f32x4* xr = (f32x4*)(args.out + (size_t)m * D_MODEL) + F.lane; const f32x4* gr = (const f32x4*)gf + F.lane;
            const u32x2* xs = (const u32x2*)(XB + (size_t)m * D_MODEL) + F.lane;
            u32x2 xw[4];
#pragma unroll
            for (int j = 0; j < 4; ++j) xw[j] = xs[64 * j];
#pragma unroll
            for (int j = 0; j < 4; ++j) { const f32x4 gg = gr[64 * j]; f32x4 v; v[0] = bflo(xw[j].x); v[1] = bfhi(xw[j].x); v[2] = bflo(xw[j].y); v[3] = bfhi(xw[j].y); xr[64 * j] = v * rs * gg; }
        }
    }
}

extern "C" void kernel_launch(void* const* d_in, const int* in_sizes, int n_in, void* d_out, int out_size, void* d_ws, size_t ws_size, hipStream_t stream) {
    static int grid = 0;
    if (grid == 0) {
        if (n_in != 20 || out_size != MTOK * D_MODEL || ws_size < WS_END) { fprintf(stderr, "kernel_launch: unexpected problem (n_in %d, out %d, ws %zu)\n", n_in, out_size, ws_size); grid = -1; return; }
        int dev = 0, cus = 0, per_cu = 0;
        if (hipGetDevice(&dev) != hipSuccess || hipDeviceGetAttribute(&cus, hipDeviceAttributeMultiprocessorCount, dev) != hipSuccess) { grid = -1; return; }
        if (hipFuncSetAttribute((const void*)trunk_fwd, hipFuncAttributeMaxDynamicSharedMemorySize, LDS_BYTES) != hipSuccess) { fprintf(stderr, "kernel_launch: hipFuncSetAttribute failed\n"); grid = -1; return; }
        if (hipOccupancyMaxActiveBlocksPerMultiprocessor(&per_cu, (const void*)trunk_fwd, NWAVES * 64, LDS_BYTES) != hipSuccess || per_cu < 1) fprintf(stderr, "kernel_launch: occupancy query reports %d\n", per_cu);
        (void)hipGetLastError();
        grid = cus < 256 ? cus : 256;
    }
    if (grid < 0) return;
    if (hipMemsetAsync((char*)d_ws + WS_CTL, 0, CTL_ZERO_BYTES, stream) != hipSuccess) return;
    Args a{};
    for (int i = 0; i < 20; ++i) a.in[i] = (const float*)d_in[i];
    a.out = (float*)d_out; a.ws = (unsigned char*)d_ws;
    hipLaunchKernelGGL(trunk_fwd, dim3(grid), dim3(NWAVES * 64), LDS_BYTES, stream, a);
}
```

```cpp
#include <hip/hip_runtime.h>
#include <cstdio>
#include <cstdint>

constexpr int D_MODEL = 1024, BATCH = 8, SEQ = 4096, DEPTH = 4, MTOK = BATCH * SEQ;
constexpr int S5_G = 16, S5_P = 16, S5_N = 64;
constexpr int DSA_H = 8, IDX_H = 4, TOPK = 256;
constexpr int RET_H = 4;
constexpr int D_FF = 2816, IN_W = 2244, NPROJ = 2304;
constexpr int PC_U = 0, PC_DQ = 256, PC_DK = 768, PC_DV = 832, PC_IK = 896, PC_IW = 960, PC_IQ = 1024, PC_RQ = 1280, PC_RK = 1536, PC_RV = 1792, PC_RG = 2048;
constexpr float RMS_EPS = 1e-6f, GN_EPS = 1e-6f;

constexpr size_t MiB = 1u << 20;
constexpr size_t WS_CTL = 0, CTL_ZERO_BYTES = 1 * MiB;
constexpr size_t WS_WIN = 2 * MiB;
constexpr size_t WS_WOUT = 20 * MiB;
constexpr size_t WS_WFFI = 28 * MiB;
constexpr size_t WS_WFFO = 72 * MiB;
constexpr size_t WS_SWF = 83 * MiB;
constexpr size_t WS_SA = 84 * MiB;
constexpr size_t WS_XQ8 = 442 * MiB;
constexpr size_t WS_WIN8 = 85 * MiB;
constexpr size_t WS_SWIN = 83 * MiB + 128 * 1024;
constexpr size_t WS_WFFI8 = 386 * MiB;
constexpr size_t WS_TAB = 94 * MiB;
constexpr size_t WS_XB = 106 * MiB;
constexpr size_t WS_SS = 170 * MiB;
constexpr size_t WS_PROJ = 172 * MiB;
constexpr size_t WS_MIX = 316 * MiB;
constexpr size_t WS_HID = 172 * MiB;
constexpr size_t HID_BX = 7 * MiB;
constexpr size_t WS_S5M = 380 * MiB;
constexpr size_t WS_S5W = 416 * MiB;
constexpr size_t WS_S5U = 424 * MiB;
constexpr size_t WS_S5E = 442 * MiB;
constexpr size_t WS_YG = 474 * MiB;
constexpr size_t WS_GLUT = 490 * MiB;
constexpr size_t WS_KVI = 492 * MiB;
constexpr size_t WS_END = 508 * MiB;
constexpr size_t TB_ROPE = 0;
constexpr size_t TB_LUT = 1 * MiB;
constexpr size_t TB_S5AB = 1 * MiB + 65536;
constexpr size_t TB_S5BB = TB_S5AB + 65536;
constexpr size_t TB_S5C = TB_S5BB + 524288;
constexpr size_t TB_POW = 3 * MiB;
constexpr size_t TB_KC = 6 * MiB;
constexpr int S5K = 1152;
constexpr size_t S5_KR_ELEMS = (size_t)16 * 16 * 128 * 16;
constexpr int KV_LD = 256, KV_DK = 0, KV_DV = 64, KV_IK = 128, KV_IW = 192;
constexpr int CW_BAR = 4096;
constexpr int CW_WORK = 16384;
constexpr int CW_GRAN = 131072;
constexpr int CW_WMAX = 65536;
constexpr int CW_WMAXI = CW_WMAX + DEPTH * 2 * D_FF;

constexpr int RING_BYTES = 131072;
constexpr int LDS_BYTES = 147456;
constexpr int MISC_OFF = LDS_BYTES - 256;
constexpr int NWAVES = 8;

#define GAS __attribute__((address_space(1)))
#define LAS __attribute__((address_space(3)))
typedef unsigned short bf16_t;
typedef short bf16x8 __attribute__((ext_vector_type(8)));
typedef float f32x4 __attribute__((ext_vector_type(4)));
typedef unsigned u32x4 __attribute__((ext_vector_type(4)));
typedef unsigned u32x2 __attribute__((ext_vector_type(2)));

__device__ __forceinline__ unsigned f2bf(float f) { unsigned u = __builtin_bit_cast(unsigned, f); return (u + 0x7fffu + ((u >> 16) & 1u)) >> 16; }
__device__ __forceinline__ unsigned pk2(float lo, float hi) { return f2bf(lo) | (f2bf(hi) << 16); }
__device__ __forceinline__ float bflo(unsigned w) { return __builtin_bit_cast(float, w << 16); }
__device__ __forceinline__ float bfhi(unsigned w) { return __builtin_bit_cast(float, w & 0xffff0000u); }
__device__ __forceinline__ unsigned pk4_f8(float a, float b, float c, float d) {
    a = __builtin_amdgcn_fmed3f(a, -448.f, 448.f); b = __builtin_amdgcn_fmed3f(b, -448.f, 448.f); c = __builtin_amdgcn_fmed3f(c, -448.f, 448.f); d = __builtin_amdgcn_fmed3f(d, -448.f, 448.f);
    int w = __builtin_amdgcn_cvt_pk_fp8_f32(a, b, 0, false); w = __builtin_amdgcn_cvt_pk_fp8_f32(c, d, w, true); return (unsigned)w; }
constexpr float F8_WS = 64.0f, F8_HS = 8.0f;
__device__ __forceinline__ float bf1(bf16_t h) { return __builtin_bit_cast(float, ((unsigned)h) << 16); }
#define LDS_WAIT() asm volatile("s_waitcnt lgkmcnt(0)" ::: "memory")
#define VM_WAIT() asm volatile("s_waitcnt vmcnt(0)" ::: "memory")
__device__ __forceinline__ int lane_id() { int z = 0; asm volatile("" : "+v"(z)); return (int)__builtin_amdgcn_mbcnt_hi(~0u, __builtin_amdgcn_mbcnt_lo(~0u, (unsigned)z)); }

typedef unsigned u32x2v __attribute__((ext_vector_type(2)));
__device__ __forceinline__ u32x2v plswap16(float v) { unsigned a = __builtin_bit_cast(unsigned, v), b = a; asm volatile("" : "+v"(b)); return __builtin_amdgcn_permlane16_swap(a, b, false, false); }
__device__ __forceinline__ u32x2v plswap32(float v) { unsigned a = __builtin_bit_cast(unsigned, v), b = a; asm volatile("" : "+v"(b)); return __builtin_amdgcn_permlane32_swap(a, b, false, false); }
__device__ __forceinline__ float x16_sum(float v) { const u32x2v r = plswap16(v); const unsigned r0 = r[0], r1 = r[1]; return __uint_as_float(r0) + __uint_as_float(r1); }
__device__ __forceinline__ float x32_sum(float v) { const u32x2v r = plswap32(v); const unsigned r0 = r[0], r1 = r[1]; return __uint_as_float(r0) + __uint_as_float(r1); }
__device__ __forceinline__ float x16_max(float v) { const u32x2v r = plswap16(v); const unsigned r0 = r[0], r1 = r[1]; return fmaxf(__uint_as_float(r0), __uint_as_float(r1)); }
__device__ __forceinline__ float x32_max(float v) { const u32x2v r = plswap32(v); const unsigned r0 = r[0], r1 = r[1]; return fmaxf(__uint_as_float(r0), __uint_as_float(r1)); }
__device__ __forceinline__ float xq_sum(float v) { return x32_sum(x16_sum(v)); }
__device__ __forceinline__ float xq_max(float v) { return x32_max(x16_max(v)); }
template <int CTRL> __device__ __forceinline__ float dpp_f(float v) { return __builtin_bit_cast(float, __builtin_amdgcn_update_dpp(0, __builtin_bit_cast(int, v), CTRL, 0xf, 0xf, true)); }
__device__ __forceinline__ float row_sum(float v) { v += dpp_f<0xB1>(v); v += dpp_f<0x4E>(v); v += dpp_f<0x141>(v); v += dpp_f<0x140>(v); return v; }
__device__ __forceinline__ float row_max(float v) { v = fmaxf(v, dpp_f<0xB1>(v)); v = fmaxf(v, dpp_f<0x4E>(v)); v = fmaxf(v, dpp_f<0x141>(v)); v = fmaxf(v, dpp_f<0x140>(v)); return v; }
__device__ __forceinline__ int bperm_i(int v, int src_lane) { return __builtin_amdgcn_ds_bpermute(src_lane << 2, v); }
__device__ __forceinline__ float bperm_f(float v, int src_lane) { return __builtin_bit_cast(float, __builtin_amdgcn_ds_bpermute(src_lane << 2, __builtin_bit_cast(int, v))); }

namespace pg8 {
#define PG8_LAS __attribute__((address_space(3)))
constexpr int BM = 256, BK = 64, HALF = 128, HTB = HALF * BK * 2, STAGE_BYTES = 8 * HTB, NXCD = 8, WGM = 8;
__host__ __device__ __forceinline__ int lds_byte(int r, int c) { const int st = (r >> 4) * 2 + (c >> 5), rr = r & 15, cc = c & 31, ob = rr * 64 + cc * 2; return st * 1024 + (ob ^ (((ob >> 9) & 1) << 5)); }
__host__ __device__ __forceinline__ void stage_rc(int b, int& R, int& C) { const int st = b / 1024, sb = b % 1024, swz = sb ^ (((sb >> 9) & 1) << 5); R = (st >> 1) * 16 + swz / 64; C = (st & 1) * 32 + (swz % 64) / 2; }
__host__ __device__ __forceinline__ int perm32(int rho) { const int n = rho >> 4, i = rho & 15; return 8 * (i >> 2) + 4 * n + (i & 3); }

typedef int i32x8v __attribute__((ext_vector_type(8)));
typedef int i32x4v __attribute__((ext_vector_type(4)));
struct Unit { int pm, pn; };
struct Gemm { const bf16_t* A; const bf16_t* Bt; int lda, ldb, K; const bf16_t* B2 = nullptr; size_t abx = 0; };

struct StaticOrder {
    int nM, nN, nwg, G, c;
    __host__ __device__ __forceinline__ void init(int M, int N, int G_, int c_) { nM = M / BM; nN = N / BM; nwg = nM * nN; G = G_; c = c_; }
    __host__ __device__ __forceinline__ bool next(int i, Unit& u) const {
        const long L = (long)i * G + c; if (L >= nwg) return false;
        int wgid = (int)L; { const int q = nwg / NXCD, r = nwg % NXCD, xcd = wgid % NXCD, off = wgid / NXCD; wgid = (xcd < r ? xcd * (q + 1) : r * (q + 1) + (xcd - r) * q) + off; }
        const int nig = WGM * nN, gid = wgid / nig, fm = gid * WGM, gsz = (nM - fm) < WGM ? (nM - fm) : WGM;
        u.pm = fm + ((wgid % nig) % gsz); u.pn = (wgid % nig) / gsz; return true;
    }
    __device__ __forceinline__ void a_ready(const Unit&) const {}
    __device__ __forceinline__ void done(const Unit&) const {}
};

__device__ __forceinline__ unsigned cvt_pk_bf16(float lo, float hi) { unsigned r; asm volatile("v_cvt_pk_bf16_f32 %0, %1, %2" : "=v"(r) : "v"(lo), "v"(hi)); return r; }

__device__ __forceinline__ float row_rstd(const float* ss, int row) {
    const f32x4* sp = (const f32x4*)(ss + (size_t)row * 16);
    const f32x4 a = sp[0], b = sp[1], c = sp[2], d = sp[3];
    const float s = ((a[0] + a[1]) + (a[2] + a[3])) + ((b[0] + b[1]) + (b[2] + b[3])) + ((c[0] + c[1]) + (c[2] + c[3])) + ((d[0] + d[1]) + (d[2] + d[3]));
    return 1.0f / sqrtf(s * (1.0f / D_MODEL) + RMS_EPS);
}
struct EpiProj {
    static constexpr bool PERM = true, AFTER_DRAIN = false;
    bf16_t* O; int ldc; const PG8_LAS float* rs_tab; bf16_t* U; bf16_t* KVI;
    __device__ __forceinline__ void operator()(const f32x4 (&acc)[2][2][4][2], const Unit& u, int wr, int wc, int fr, int fq, int ui) const {
        const int row0 = u.pm * BM + wr * 64 + fr, col0 = u.pn * BM + wc * 32 + 8 * fq;
#pragma unroll
        for (int ai = 0; ai < 2; ++ai)
#pragma unroll
            for (int m = 0; m < 4; ++m) { const int row = row0 + ai * HALF + m * 16; const float rs = rs_tab[ui * 256 + (row - u.pm * BM)]; bf16_t* rowp = O + (size_t)row * ldc + col0;
#pragma unroll
                for (int bj = 0; bj < 2; ++bj) { const f32x4 v0 = acc[ai][bj][m][0] * rs, v1 = acc[ai][bj][m][1] * rs;
                    u32x4 w; w.x = cvt_pk_bf16(v0[0], v0[1]); w.y = cvt_pk_bf16(v0[2], v0[3]); w.z = cvt_pk_bf16(v1[0], v1[1]); w.w = cvt_pk_bf16(v1[2], v1[3]);
                    if (u.pn == 0) { const int ch = col0 + bj * HALF; *(u32x4*)(U + ((size_t)(ch >> 4) * 512 + (row >> 6)) * S5K + (row & 63) * 16 + (ch & 15)) = w; }
                    else if (u.pn == 3) *(u32x4*)(KVI + (size_t)row * KV_LD + (col0 - 3 * BM) + bj * HALF) = w;
                    else *(u32x4*)(rowp + bj * HALF) = w; } }
    }
};
struct EpiProjI {
    static constexpr bool PERM = true, AFTER_DRAIN = false;
    bf16_t* O; int ldc; const PG8_LAS float* rs_tab; bf16_t* U; bf16_t* KVI; const float* sw;
    __device__ __forceinline__ void operator()(const f32x4 (&acc)[2][2][4][2], const Unit& u, int wr, int wc, int fr, int fq, int ui) const {
        const int row0 = u.pm * BM + wr * 64 + fr, col0 = u.pn * BM + wc * 32 + 8 * fq;
        f32x4 sc[2][2];
#pragma unroll
        for (int bj = 0; bj < 2; ++bj) { sc[bj][0] = *(const f32x4*)(sw + col0 + bj * HALF); sc[bj][1] = *(const f32x4*)(sw + col0 + bj * HALF + 4); }
#pragma unroll
        for (int ai = 0; ai < 2; ++ai)
#pragma unroll
            for (int m = 0; m < 4; ++m) { const int row = row0 + ai * HALF + m * 16; const float rs = rs_tab[ui * 256 + (row - u.pm * BM)]; bf16_t* rowp = O + (size_t)row * ldc + col0;
#pragma unroll
                for (int bj = 0; bj < 2; ++bj) { const f32x4 a0_ = acc[ai][bj][m][0], a1_ = acc[ai][bj][m][1];
                    const float af[8] = {a0_[0], a0_[1], a0_[2], a0_[3], a1_[0], a1_[1], a1_[2], a1_[3]};
                    const f32x4 s0 = sc[bj][0] * rs, s1 = sc[bj][1] * rs;
                    const float v[8] = {(float)__float_as_int(af[0]) * s0[0], (float)__float_as_int(af[1]) * s0[1], (float)__float_as_int(af[2]) * s0[2], (float)__float_as_int(af[3]) * s0[3],
                                        (float)__float_as_int(af[4]) * s1[0], (float)__float_as_int(af[5]) * s1[1], (float)__float_as_int(af[6]) * s1[2], (float)__float_as_int(af[7]) * s1[3]};
                    u32x4 w; w.x = cvt_pk_bf16(v[0], v[1]); w.y = cvt_pk_bf16(v[2], v[3]); w.z = cvt_pk_bf16(v[4], v[5]); w.w = cvt_pk_bf16(v[6], v[7]);
                    if (u.pn == 0) { const int ch = col0 + bj * HALF; *(u32x4*)(U + ((size_t)(ch >> 4) * 512 + (row >> 6)) * S5K + (row & 63) * 16 + (ch & 15)) = w; }
                    else if (u.pn == 3) *(u32x4*)(KVI + (size_t)row * KV_LD + (col0 - 3 * BM) + bj * HALF) = w;
                    else *(u32x4*)(rowp + bj * HALF) = w; } }
    }
};
struct EpiS5State {
    static constexpr bool PERM = false, AFTER_DRAIN = false;
    float* E;
    __device__ __forceinline__ void operator()(const f32x4 (&acc)[2][2][4][2], const Unit&, int wr, int wc, int fr, int fq, int ui) const {
#pragma unroll
        for (int ai = 0; ai < 2; ++ai)
#pragma unroll
            for (int m = 0; m < 4; ++m) { const int r = ai * HALF + wr * 64 + m * 16 + fr;
#pragma unroll
                for (int n = 0; n < 2; ++n) *(f32x4*)(E + (size_t)r * 128 + wc * 32 + 16 * n + 4 * fq) = acc[ai][0][m][n]; }
    }
};
__device__ __forceinline__ float gelu_tanh_f(float y) {
    const float t = 0.7978845608028654f * (y + 0.044715f * y * y * y);
    const float e = __expf(2.0f * t);
    return y * (1.0f - __builtin_amdgcn_rcpf(e + 1.0f));
}
struct EpiS5Y {
    static constexpr bool PERM = true, AFTER_DRAIN = false;
    bf16_t* YG; int g;
    __device__ __forceinline__ void operator()(const f32x4 (&acc)[2][2][4][2], const Unit& u, int wr, int wc, int fr, int fq, int ui) const {
        const int row0 = u.pm * BM + wr * 64 + fr, col0 = u.pn * BM + wc * 32 + 8 * fq;
#pragma unroll
        for (int ai = 0; ai < 2; ++ai)
#pragma unroll
            for (int m = 0; m < 4; ++m) { const int row = row0 + ai * HALF + m * 16;
#pragma unroll
                for (int bj = 0; bj < 2; ++bj) { const int c = col0 + bj * HALF; const f32x4 a0 = acc[ai][bj][m][0], a1 = acc[ai][bj][m][1];
                    u32x4 w; w.x = cvt_pk_bf16(gelu_tanh_f(a0[0]), gelu_tanh_f(a0[1])); w.y = cvt_pk_bf16(gelu_tanh_f(a0[2]), gelu_tanh_f(a0[3]));
                    w.z = cvt_pk_bf16(gelu_tanh_f(a1[0]), gelu_tanh_f(a1[1])); w.w = cvt_pk_bf16(gelu_tanh_f(a1[2]), gelu_tanh_f(a1[3]));
                    *(u32x4*)(YG + ((size_t)row * 64 + (c >> 4)) * 256 + 16 * g + (c & 15)) = w; } }
    }
};
struct EpiGLU {
    static constexpr bool PERM = true, AFTER_DRAIN = false;
    const bf16_t* YG; bf16_t* MIX; const float* bias;
    __device__ __forceinline__ void operator()(const f32x4 (&acc)[2][2][4][2], const Unit& u, int wr, int wc, int fr, int fq, int ui) const {
        const int row0 = u.pm * BM + wr * 64 + fr, col0 = wc * 32 + 8 * fq;
#pragma unroll
        for (int ai = 0; ai < 2; ++ai)
#pragma unroll
            for (int m = 0; m < 4; ++m) { const int row = row0 + ai * HALF + m * 16;
#pragma unroll
                for (int bj = 0; bj < 2; ++bj) { const int c = col0 + bj * HALF;
                    const u32x4 yv = *(const u32x4*)(YG + (size_t)row * 256 + c);
                    const f32x4 b0 = *(const f32x4*)(bias + c), b1 = *(const f32x4*)(bias + c + 4);
                    const f32x4 z0 = acc[ai][bj][m][0] + b0, z1 = acc[ai][bj][m][1] + b1;
                    const float y[8] = {bflo(yv.x), bfhi(yv.x), bflo(yv.y), bfhi(yv.y), bflo(yv.z), bfhi(yv.z), bflo(yv.w), bfhi(yv.w)};
                    float o[8];
#pragma unroll
                    for (int j = 0; j < 4; ++j) { o[j] = y[j] * __builtin_amdgcn_rcpf(1.0f + __expf(-z0[j])); o[4 + j] = y[4 + j] * __builtin_amdgcn_rcpf(1.0f + __expf(-z1[j])); }
                    u32x4 w; w.x = cvt_pk_bf16(o[0], o[1]); w.y = cvt_pk_bf16(o[2], o[3]); w.z = cvt_pk_bf16(o[4], o[5]); w.w = cvt_pk_bf16(o[6], o[7]);
                    *(u32x4*)(MIX + (size_t)row * 1024 + c) = w; } }
    }
};
struct RowUnits {
    int pm, n;
    __device__ __forceinline__ bool next(int i, Unit& u) const { if (i >= n) return false; u.pm = pm; u.pn = i; return true; }
    __device__ __forceinline__ void a_ready(const Unit&) const {}
    __device__ __forceinline__ void done(const Unit&) const {}
};
struct SingleUnit {
    int pm, pn;
    __device__ __forceinline__ bool next(int i, Unit& u) const { if (i != 0) return false; u.pm = pm; u.pn = pn; return true; }
    __device__ __forceinline__ void a_ready(const Unit&) const {}
    __device__ __forceinline__ void done(const Unit&) const {}
};
struct EpiSwiGLU {
    static constexpr bool PERM = true, AFTER_DRAIN = false;
    bf16_t* O; int ldc; const PG8_LAS float* rs_tab;
    __device__ __forceinline__ void operator()(const f32x4 (&acc)[2][2][4][2], const Unit& u, int wr, int wc, int fr, int fq, int ui) const {
        const int row0 = u.pm * BM + wr * 64 + fr, col0 = u.pn * HALF + wc * 32 + 8 * fq;
#pragma unroll
        for (int ai = 0; ai < 2; ++ai)
#pragma unroll
            for (int m = 0; m < 4; ++m) { const int row = row0 + ai * HALF + m * 16; const float rs = rs_tab[ui * 256 + (row - u.pm * BM)];
                float h[8];
#pragma unroll
                for (int n = 0; n < 2; ++n)
#pragma unroll
                    for (int j = 0; j < 4; ++j) { const float g = acc[ai][0][m][n][j] * rs, up = acc[ai][1][m][n][j] * rs; h[n * 4 + j] = g * __builtin_amdgcn_rcpf(1.0f + __expf(-g)) * up; }
                u32x4 w; w.x = cvt_pk_bf16(h[0], h[1]); w.y = cvt_pk_bf16(h[2], h[3]); w.z = cvt_pk_bf16(h[4], h[5]); w.w = cvt_pk_bf16(h[6], h[7]);
                *(u32x4*)(O + (size_t)row * ldc + col0) = w; }
    }
};
struct EpiSwiGLU8 {
    static constexpr bool PERM = true, AFTER_DRAIN = false;
    unsigned char* O; int ldc; const PG8_LAS float* rs_tab;
    __device__ __forceinline__ void operator()(const f32x4 (&acc)[2][2][4][2], const Unit& u, int wr, int wc, int fr, int fq, int ui) const {
        const int row0 = u.pm * BM + wr * 64 + fr, col0 = u.pn * HALF + wc * 32 + 8 * fq;
#pragma unroll
        for (int ai = 0; ai < 2; ++ai)
#pragma unroll
            for (int m = 0; m < 4; ++m) { const int row = row0 + ai * HALF + m * 16; const float rs = rs_tab[ui * 256 + (row - u.pm * BM)];
                float h[8];
#pragma unroll
                for (int n = 0; n < 2; ++n)
#pragma unroll
                    for (int j = 0; j < 4; ++j) { const float g = acc[ai][0][m][n][j] * rs, up = acc[ai][1][m][n][j] * rs; h[n * 4 + j] = g * __builtin_amdgcn_rcpf(1.0f + __expf(-g)) * up * F8_HS; }
                u32x2 w; w.x = pk4_f8(h[0], h[1], h[2], h[3]); w.y = pk4_f8(h[4], h[5], h[6], h[7]);
                *(u32x2*)(O + (size_t)row * ldc + col0) = w; }
    }
};
struct EpiSwiGLU8I {
    static constexpr bool PERM = true, AFTER_DRAIN = false;
    unsigned char* O; int ldc; const PG8_LAS float* rs_tab; const PG8_LAS float* sw; size_t obx; int pm0;
    __device__ __forceinline__ void operator()(const f32x4 (&acc)[2][2][4][2], const Unit& u, int wr, int wc, int fr, int fq, int ui) const {
        const int row0 = u.pm * BM + wr * 64 + fr, cl = wc * 32 + 8 * fq, col0 = u.pn * HALF + cl;
        const f32x4 sg0 = *(const PG8_LAS f32x4*)(sw + ui * BM + cl), sg1 = *(const PG8_LAS f32x4*)(sw + ui * BM + cl + 4), su0 = *(const PG8_LAS f32x4*)(sw + ui * BM + HALF + cl), su1 = *(const PG8_LAS f32x4*)(sw + ui * BM + HALF + cl + 4);
        const float sgv[8] = {sg0[0], sg0[1], sg0[2], sg0[3], sg1[0], sg1[1], sg1[2], sg1[3]}, suv[8] = {su0[0], su0[1], su0[2], su0[3], su1[0], su1[1], su1[2], su1[3]};
#pragma unroll
        for (int ai = 0; ai < 2; ++ai)
#pragma unroll
            for (int m = 0; m < 4; ++m) { const int row = row0 + ai * HALF + m * 16; const float rs = rs_tab[((u.pm - pm0) >> 3) * 256 + (row - u.pm * BM)];
                float h[8];
#pragma unroll
                for (int n = 0; n < 2; ++n) { const f32x4 ag_ = acc[ai][0][m][n], au_ = acc[ai][1][m][n];
                    const float agf[4] = {ag_[0], ag_[1], ag_[2], ag_[3]}, auf[4] = {au_[0], au_[1], au_[2], au_[3]};
#pragma unroll
                    for (int j = 0; j < 4; ++j) { const float g = (float)__float_as_int(agf[j]) * (rs * sgv[n * 4 + j]), up = (float)__float_as_int(auf[j]) * (rs * suv[n * 4 + j]);
                        h[n * 4 + j] = g * __builtin_amdgcn_rcpf(1.0f + __expf(-g)) * up * F8_HS; } }
                u32x2 w; w.x = pk4_f8(h[0], h[1], h[2], h[3]); w.y = pk4_f8(h[4], h[5], h[6], h[7]);
                *(u32x2*)(O + (size_t)row * ldc + col0 + (size_t)(u.pm >> 4) * obx) = w; }
    }
};
struct EpiResid {
    static constexpr bool PERM = true, AFTER_DRAIN = false;
    const float* xin; float* xout; bf16_t* xb; float* ss;
    __device__ __forceinline__ void operator()(const f32x4 (&acc)[2][2][4][2], const Unit& u, int wr, int wc, int fr, int fq, int ui) const {
        const int row0 = u.pm * BM + wr * 64 + fr, col0 = u.pn * BM + wc * 32 + 8 * fq;
#pragma unroll
        for (int ai = 0; ai < 2; ++ai) {
            f32x4 xv[4][2][2];
#pragma unroll
            for (int m = 0; m < 4; ++m)
#pragma unroll
                for (int bj = 0; bj < 2; ++bj) { const size_t off = (size_t)(row0 + ai * HALF + m * 16) * D_MODEL + col0 + bj * HALF;
                    xv[m][bj][0] = *(const f32x4*)(xin + off); xv[m][bj][1] = *(const f32x4*)(xin + off + 4); }
            __builtin_amdgcn_sched_barrier(0);
#pragma unroll
            for (int m = 0; m < 4; ++m) { const int row = row0 + ai * HALF + m * 16; float sq = 0.f;
#pragma unroll
                for (int bj = 0; bj < 2; ++bj) { const size_t off = (size_t)row * D_MODEL + col0 + bj * HALF;
                    const f32x4 x0 = xv[m][bj][0] + acc[ai][bj][m][0], x1 = xv[m][bj][1] + acc[ai][bj][m][1];
                    *(f32x4*)(xout + off) = x0; *(f32x4*)(xout + off + 4) = x1;
                    u32x4 w; w.x = cvt_pk_bf16(x0[0], x0[1]); w.y = cvt_pk_bf16(x0[2], x0[3]); w.z = cvt_pk_bf16(x1[0], x1[1]); w.w = cvt_pk_bf16(x1[2], x1[3]);
                    *(u32x4*)(xb + off) = w;
                    sq += (x0[0] * x0[0] + x0[1] * x0[1]) + (x0[2] * x0[2] + x0[3] * x0[3]) + (x1[0] * x1[0] + x1[1] * x1[1]) + (x1[2] * x1[2] + x1[3] * x1[3]); }
                sq = xq_sum(sq);
                if (fq == 0) ss[(size_t)row * 16 + u.pn * 4 + wc] = sq; }
            __builtin_amdgcn_sched_barrier(0);
        }
    }
};

struct EpiResidB {
    static constexpr bool PERM = true, AFTER_DRAIN = false;
    bf16_t* xb; float* ss; float asc; int rmax_off;
    __device__ __forceinline__ void operator()(const f32x4 (&acc)[2][2][4][2], const Unit& u, int wr, int wc, int fr, int fq, int ui) const {
        const int row0 = u.pm * BM + wr * 64 + fr, col0 = u.pn * BM + wc * 32 + 8 * fq;
#pragma unroll
        for (int ai = 0; ai < 2; ++ai) {
            u32x4 xv[4][2];
#pragma unroll
            for (int m = 0; m < 4; ++m)
#pragma unroll
                for (int bj = 0; bj < 2; ++bj) xv[m][bj] = *(const u32x4*)(xb + (size_t)(row0 + ai * HALF + m * 16) * D_MODEL + col0 + bj * HALF);
            __builtin_amdgcn_sched_barrier(0);
#pragma unroll
            for (int m = 0; m < 4; ++m) { const int row = row0 + ai * HALF + m * 16; float sq = 0.f, mxr = 0.f;
#pragma unroll
                for (int bj = 0; bj < 2; ++bj) { const size_t off = (size_t)row * D_MODEL + col0 + bj * HALF; const u32x4 v = xv[m][bj];
                    const f32x4 a0 = acc[ai][bj][m][0] * asc, a1 = acc[ai][bj][m][1] * asc;
                    u32x4 w; w.x = cvt_pk_bf16(bflo(v.x) + a0[0], bfhi(v.x) + a0[1]); w.y = cvt_pk_bf16(bflo(v.y) + a0[2], bfhi(v.y) + a0[3]);
                    w.z = cvt_pk_bf16(bflo(v.z) + a1[0], bfhi(v.z) + a1[1]); w.w = cvt_pk_bf16(bflo(v.w) + a1[2], bfhi(v.w) + a1[3]);
                    *(u32x4*)(xb + off) = w;
                    const float y0 = bflo(w.x), y1 = bfhi(w.x), y2 = bflo(w.y), y3 = bfhi(w.y), y4 = bflo(w.z), y5 = bfhi(w.z), y6 = bflo(w.w), y7 = bfhi(w.w);

                    sq += (y0 * y0 + y1 * y1) + (y2 * y2 + y3 * y3) + (y4 * y4 + y5 * y5) + (y6 * y6 + y7 * y7);
                    mxr = fmaxf(fmaxf(mxr, fmaxf(fmaxf(fabsf(y0), fabsf(y1)), fmaxf(fabsf(y2), fabsf(y3)))), fmaxf(fmaxf(fabsf(y4), fabsf(y5)), fmaxf(fabsf(y6), fabsf(y7)))); }
                sq = xq_sum(sq); mxr = xq_max(mxr);
                if (fq == 0) { ss[(size_t)row * 16 + u.pn * 4 + wc] = sq; extern __shared__ __attribute__((aligned(16))) unsigned lds_rawu[];
                    __hip_atomic_fetch_max((PG8_LAS unsigned*)lds_rawu + (rmax_off >> 2) + ui * BM + (row - u.pm * BM), __float_as_uint(mxr), __ATOMIC_RELAXED, __HIP_MEMORY_SCOPE_WORKGROUP); } }
            __builtin_amdgcn_sched_barrier(0);
        }
    }
};

template <class Epi, class Sched, bool ALIGN_EPI = false, bool SP2 = false, int WIN = 0, int F8 = 0>
__device__ __forceinline__ void gemm_phase(PG8_LAS unsigned char* lds, const Gemm g, const Sched& S, const Epi& E, int wave_) {
    static_assert(!WIN || SP2, "WIN is written for the SP2 schedule");
    int wid_ = wave_; asm volatile("" : "+s"(wid_));
    const int wid = wid_, lane = lane_id(), tid = wid * 64 + lane, wr = wid >> 2, wc = wid & 3, fr = lane & 15, fq = lane >> 4;
    const int K = g.K, nt = K / BK;
    constexpr int NT1 = 16;
    unsigned voffA[2], voffB[2], voffB2[2];
#pragma unroll
    for (int i = 0; i < 2; ++i) { int R, C; stage_rc(tid * 16 + i * 8192, R, C); const int Rb = Epi::PERM ? ((R & ~31) + perm32(R & 31)) : R;
        voffA[i] = (unsigned)(R * g.lda + C) * 2u;
        voffB[i] = WIN ? (unsigned)((Rb & 15) * 2048 + (7 - (Rb >> 4)) * 16 + C) * 2u : (unsigned)(Rb * g.ldb + C) * 2u;
        voffB2[i] = (unsigned)(Rb * 128 + C) * 2u; }
    const size_t kstep = (size_t)(BK * 2);
    const size_t hstepA = (size_t)HALF * g.lda * 2; const long hstepB = WIN ? -256L : (long)HALF * g.ldb * 2, hstepB2 = (long)HALF * 128 * 2;
    const size_t tstepA = 2 * hstepA; const long tstepB = 2 * hstepB, tstepB2 = 2 * hstepB2;
    const char* Bbase = (const char*)g.Bt + (WIN ? 56 * 32 : 0);
    const unsigned ldsw = (unsigned)wid * 1024u;
    const int aoff = lds_byte(wr * 64 + fr, F8 == 1 ? fq * 16 : fq * 8), boff = lds_byte(wc * 32 + fr, F8 == 1 ? fq * 16 : fq * 8);
#define PG8_SA(b, h) (((b) * 2 + (h)) * HTB)
#define PG8_SB(b, h) ((4 + (b) * 2 + (h)) * HTB)
#define PG8_STAGE(bufoff, gbase, voff) do { _Pragma("unroll") for (int _i = 0; _i < 2; ++_i) \
        __builtin_amdgcn_global_load_lds((const unsigned*)((const char*)(gbase) + (voff)[_i]), (PG8_LAS unsigned*)(lds + (bufoff) + ldsw + _i * 8192), 16, 0, 0); } while (0)
#define PG8_LD8(p_) __builtin_shufflevector(*(const PG8_LAS i32x4v*)(p_), *(const PG8_LAS i32x4v*)((p_) + 16), 0, 1, 2, 3, 4, 5, 6, 7)
#define PG8_LDA(dst, b, h) do { if constexpr (F8 == 1) { _Pragma("unroll") for (int m = 0; m < 4; ++m) dst##8[m] = PG8_LD8(lds + PG8_SA(b, h) + aoff + m * 2048); } \
        else { _Pragma("unroll") for (int m = 0; m < 4; ++m) _Pragma("unroll") for (int k = 0; k < 2; ++k) dst[m][k] = *(const PG8_LAS bf16x8*)(lds + PG8_SA(b, h) + aoff + m * 2048 + k * 1024); } } while (0)
#define PG8_LDB(dst, b, h) do { if constexpr (F8 == 1) { _Pragma("unroll") for (int n = 0; n < 2; ++n) dst##8[n] = PG8_LD8(lds + PG8_SB(b, h) + boff + n * 2048); } \
        else { _Pragma("unroll") for (int n = 0; n < 2; ++n) _Pragma("unroll") for (int k = 0; k < 2; ++k) dst[n][k] = *(const PG8_LAS bf16x8*)(lds + PG8_SB(b, h) + boff + n * 2048 + k * 1024); } } while (0)
#define PG8_SUB8(v, i0, i1) __builtin_bit_cast(long, __builtin_shufflevector(v, v, i0, i1))
#define PG8_MMA(ai, bj, At, Bt) do { __builtin_amdgcn_s_setprio(1); \
        if constexpr (F8 == 3) { _Pragma("unroll") for (int m = 0; m < 4; ++m) _Pragma("unroll") for (int n = 0; n < 2; ++n) _Pragma("unroll") for (int k = 0; k < 2; ++k)   \
            acc[ai][bj][m][n] = __builtin_bit_cast(f32x4, __builtin_amdgcn_mfma_i32_16x16x64_i8(__builtin_bit_cast(i32x4v, Bt[n][k]), __builtin_bit_cast(i32x4v, At[m][k]), __builtin_bit_cast(i32x4v, acc[ai][bj][m][n]), 0, 0, 0)); } \
        else if constexpr (F8 == 1) { _Pragma("unroll") for (int m = 0; m < 4; ++m) _Pragma("unroll") for (int n = 0; n < 2; ++n) { \
            acc[ai][bj][m][n] = __builtin_amdgcn_mfma_f32_16x16x32_fp8_fp8(PG8_SUB8(Bt##8[n], 0, 1), PG8_SUB8(At##8[m], 0, 1), acc[ai][bj][m][n], 0, 0, 0); \
            acc[ai][bj][m][n] = __builtin_amdgcn_mfma_f32_16x16x32_fp8_fp8(PG8_SUB8(Bt##8[n], 2, 3), PG8_SUB8(At##8[m], 2, 3), acc[ai][bj][m][n], 0, 0, 0); \
            acc[ai][bj][m][n] = __builtin_amdgcn_mfma_f32_16x16x32_fp8_fp8(PG8_SUB8(Bt##8[n], 4, 5), PG8_SUB8(At##8[m], 4, 5), acc[ai][bj][m][n], 0, 0, 0); \
            acc[ai][bj][m][n] = __builtin_amdgcn_mfma_f32_16x16x32_fp8_fp8(PG8_SUB8(Bt##8[n], 6, 7), PG8_SUB8(At##8[m], 6, 7), acc[ai][bj][m][n], 0, 0, 0); } } \
        else { _Pragma("unroll") for (int m = 0; m < 4; ++m) _Pragma("unroll") for (int n = 0; n < 2; ++n) _Pragma("unroll") for (int k = 0; k < 2; ++k) \
            acc[ai][bj][m][n] = __builtin_amdgcn_mfma_f32_16x16x32_bf16(Bt[n][k], At[m][k], acc[ai][bj][m][n], 0, 0, 0); } \
        __builtin_amdgcn_s_setprio(0); } while (0)
#define PG8_WAIT_V(n) asm volatile("s_waitcnt vmcnt(" #n ")" ::: "memory")
#define PG8_WAIT_L(n) asm volatile("s_waitcnt lgkmcnt(" #n ")" ::: "memory")
#define PG8_BAR __builtin_amdgcn_s_barrier()
#define PG8_SCHED __builtin_amdgcn_sched_barrier(0)
    Unit cur, nxt; int ui = 0;
    if (!S.next(0, cur)) return;
    f32x4 acc[2][2][4][2];
#pragma unroll
    for (int a = 0; a < 2; ++a)
#pragma unroll
        for (int b = 0; b < 2; ++b)
#pragma unroll
            for (int m = 0; m < 4; ++m)
#pragma unroll
                for (int n = 0; n < 2; ++n) acc[a][b][m][n] = (f32x4){0.f, 0.f, 0.f, 0.f};
    bf16x8 At[4][2], B0[2][2], B1[2][2]; i32x8v At8[4], B08[2], B18[2];
    const char* cA = (const char*)g.A + (size_t)cur.pm * tstepA + (size_t)(cur.pm >> 4) * g.abx; const char* cB = Bbase + (long)cur.pn * tstepB; const char* cB2 = (const char*)g.B2 + (long)cur.pn * tstepB2;
    S.a_ready(cur);
    if constexpr (SP2) {
        PG8_STAGE(PG8_SB(0, 0), cB, voffB); PG8_STAGE(PG8_SB(0, 1), cB + hstepB, voffB); PG8_STAGE(PG8_SA(0, 0), cA, voffA); PG8_STAGE(PG8_SA(0, 1), cA + hstepA, voffA);
        if (wr == 1) PG8_BAR;
        PG8_WAIT_V(2); PG8_BAR;
        PG8_STAGE(PG8_SB(1, 0), cB + kstep, voffB); PG8_STAGE(PG8_SA(1, 0), cA + kstep, voffA); PG8_STAGE(PG8_SB(1, 1), cB + hstepB + kstep, voffB);
        PG8_WAIT_V(6); PG8_BAR;
    } else {
        PG8_STAGE(PG8_SB(0, 0), cB, voffB); PG8_STAGE(PG8_SA(0, 0), cA, voffA); PG8_STAGE(PG8_SB(0, 1), cB + hstepB, voffB); PG8_STAGE(PG8_SA(0, 1), cA + hstepA, voffA);
        if (wr == 1) PG8_BAR;
        PG8_WAIT_V(4); PG8_BAR;
        PG8_STAGE(PG8_SB(1, 0), cB + kstep, voffB); PG8_STAGE(PG8_SA(1, 0), cA + kstep, voffA); PG8_STAGE(PG8_SB(1, 1), cB + hstepB + kstep, voffB);
        PG8_WAIT_V(6); PG8_BAR;
    }
    for (;;) {
        const bool has_next = S.next(ui + 1, nxt);
        const char* nA = has_next ? (const char*)g.A + (size_t)nxt.pm * tstepA + (size_t)(nxt.pm >> 4) * g.abx : cA; const char* nB = has_next ? Bbase + (long)nxt.pn * tstepB : cB;
        const char* nB2 = has_next ? (const char*)g.B2 + (long)nxt.pn * tstepB2 : cB2;
        for (int t = 0; t < nt; t += 2) {
            const bool last = (t == nt - 2);
            const char* a1 = cA + (size_t)(t + 1) * kstep;
            const bool s2 = WIN && !last && (t + 2 >= NT1);
            const char* a2 = last ? nA : cA + (size_t)(t + 2) * kstep; const char* b2 = last ? nB : (s2 ? cB2 + (size_t)(t + 2 - NT1) * kstep : cB + (size_t)(t + 2) * kstep);
            const char* a3 = a2 + kstep; const char* b3 = b2 + kstep;
            unsigned vbs[2]; vbs[0] = s2 ? voffB2[0] : voffB[0]; vbs[1] = s2 ? voffB2[1] : voffB[1]; const long hbs = s2 ? hstepB2 : hstepB;
            if (last && has_next) S.a_ready(nxt);
            if constexpr (SP2) {
            PG8_LDB(B0, 0, 0); PG8_LDB(B1, 0, 1); PG8_SCHED; PG8_LDA(At, 0, 0); PG8_STAGE(PG8_SA(1, 1), a1 + hstepA, voffA);
            PG8_WAIT_V(8); PG8_WAIT_L(0); PG8_BAR; PG8_MMA(0, 0, At, B0); PG8_MMA(0, 1, At, B1); PG8_BAR; PG8_SCHED;
            PG8_LDA(At, 0, 1); PG8_STAGE(PG8_SB(0, 0), b2, vbs); PG8_STAGE(PG8_SB(0, 1), b2 + hbs, vbs); PG8_STAGE(PG8_SA(0, 0), a2, voffA);
            PG8_WAIT_V(8); PG8_WAIT_L(0); PG8_BAR; PG8_MMA(1, 0, At, B0); PG8_MMA(1, 1, At, B1); PG8_BAR; PG8_SCHED;
            PG8_LDB(B0, 1, 0); PG8_LDB(B1, 1, 1); PG8_SCHED; PG8_LDA(At, 1, 0); PG8_STAGE(PG8_SA(0, 1), a2 + hstepA, voffA);
            PG8_WAIT_V(8); PG8_WAIT_L(0); PG8_BAR; PG8_MMA(0, 0, At, B0); PG8_MMA(0, 1, At, B1); PG8_BAR; PG8_SCHED;
            PG8_LDA(At, 1, 1); PG8_STAGE(PG8_SB(1, 0), b3, vbs); PG8_STAGE(PG8_SB(1, 1), b3 + hbs, vbs); PG8_STAGE(PG8_SA(1, 0), a3, voffA);
            PG8_WAIT_V(8); PG8_WAIT_L(0); PG8_BAR; PG8_MMA(1, 0, At, B0); PG8_MMA(1, 1, At, B1); PG8_BAR; PG8_SCHED;
            } else {
            PG8_LDB(B0, 0, 0); PG8_SCHED; PG8_LDA(At, 0, 0); PG8_STAGE(PG8_SA(1, 1), a1 + hstepA, voffA);
            PG8_WAIT_L(8); PG8_BAR; PG8_WAIT_L(0); PG8_MMA(0, 0, At, B0); PG8_BAR; PG8_SCHED;
            PG8_LDB(B1, 0, 1); PG8_STAGE(PG8_SB(0, 0), b2, voffB);
            PG8_BAR; PG8_WAIT_L(0); PG8_MMA(0, 1, At, B1); PG8_BAR;
            PG8_LDA(At, 0, 1); PG8_STAGE(PG8_SA(0, 0), a2, voffA);
            PG8_BAR; PG8_WAIT_L(0); PG8_MMA(1, 0, At, B0); PG8_BAR; PG8_SCHED;
            PG8_STAGE(PG8_SB(0, 1), b2 + hstepB, voffB);
            PG8_WAIT_V(6); PG8_BAR; PG8_MMA(1, 1, At, B1); PG8_BAR;
            PG8_LDB(B0, 1, 0); PG8_SCHED; PG8_LDA(At, 1, 0); PG8_STAGE(PG8_SA(0, 1), a2 + hstepA, voffA);
            PG8_WAIT_L(8); PG8_BAR; PG8_WAIT_L(0); PG8_MMA(0, 0, At, B0); PG8_BAR; PG8_SCHED;
            PG8_LDB(B1, 1, 1); PG8_STAGE(PG8_SB(1, 0), b3, voffB);
            PG8_BAR; PG8_WAIT_L(0); PG8_MMA(0, 1, At, B1); PG8_BAR;
            PG8_LDA(At, 1, 1); PG8_STAGE(PG8_SA(1, 0), a3, voffA);
            PG8_BAR; PG8_WAIT_L(0); PG8_MMA(1, 0, At, B0); PG8_BAR; PG8_SCHED;
            PG8_STAGE(PG8_SB(1, 1), b3 + hstepB, voffB);
            PG8_WAIT_V(6); PG8_BAR; PG8_MMA(1, 1, At, B1); PG8_BAR;
            }
        }
        if constexpr (ALIGN_EPI) { if (wr == 0) PG8_BAR; }
        if constexpr (!Epi::AFTER_DRAIN) { const int l2_ = lane_id(); E(acc, cur, wr, wc, l2_ & 15, l2_ >> 4, ui); S.done(cur); }
        if (!has_next) break;
#pragma unroll
        for (int a = 0; a < 2; ++a)
#pragma unroll
            for (int b = 0; b < 2; ++b)
#pragma unroll
                for (int m = 0; m < 4; ++m)
#pragma unroll
                    for (int n = 0; n < 2; ++n) acc[a][b][m][n] = (f32x4){0.f, 0.f, 0.f, 0.f};
        cur = nxt; cA = nA; cB = nB; cB2 = nB2; ++ui;
        if constexpr (ALIGN_EPI) { if (wr == 1) PG8_BAR; }
    }
    PG8_WAIT_V(0);
    if constexpr (!ALIGN_EPI) { if (wr == 0) PG8_BAR; }
    PG8_BAR;
#undef PG8_SA
#undef PG8_SB
#undef PG8_STAGE
#undef PG8_LDA
#undef PG8_LDB
#undef PG8_MMA
#undef PG8_WAIT_V
#undef PG8_WAIT_L
#undef PG8_BAR
#undef PG8_SCHED
}
}

#define XB_TMO      128
#define XB_XCNT(j)  (256  + 64 * (j))
#define XB_XSUB(j)  (1280 + 64 * (j))
#define XB_XGEN(j)  (2304 + 64 * (j))
#define XB_TOP      3328
#define XB_TOPGEN   3392
#define XCD_BAR_WORDS 3456
#define XB_MISM     192
#define XB_LSUB(j)  (4096 + 64 * (j))
#define XB_LGEN(j)  (5120 + 64 * (j))
#define XB_SPIN_CAP (1u << 18)
__device__ __forceinline__ unsigned xb_ld(unsigned* p)              { return __hip_atomic_load(p, __ATOMIC_RELAXED, __HIP_MEMORY_SCOPE_AGENT); }
__device__ __forceinline__ unsigned xb_add(unsigned* p, unsigned v) { return __hip_atomic_fetch_add(p, v, __ATOMIC_RELAXED, __HIP_MEMORY_SCOPE_AGENT); }
__device__ __forceinline__ unsigned xb_xcc_id() { return (unsigned)__builtin_amdgcn_s_getreg((3 << 11) | 20) & 0xFu; }
#define XB_SPIN(cond, bar) do { unsigned _sp = 0; while (cond) { __builtin_amdgcn_s_sleep(1); \
    if ((++_sp & 255u) == 0u) { if (xb_ld(&(bar)[XB_TMO])) break; if (_sp > XB_SPIN_CAP) { atomicAdd(&(bar)[XB_TMO], 1u); break; } } } } while (0)
struct XcdBarrier { unsigned* bar; unsigned x; volatile LAS unsigned* st; };
__device__ __forceinline__ XcdBarrier xcd_barrier_post(unsigned* bar, volatile LAS unsigned* st, bool leader) {
    XcdBarrier b; b.bar = bar; b.x = xb_xcc_id(); b.st = st;
    if (leader) (void)xb_add(&bar[XB_XCNT(b.x)], 1u);
    return b;
}
__device__ __forceinline__ void xcd_barrier_complete(unsigned* bar, unsigned x, unsigned& nloc, unsigned& nx) {
    const unsigned G = gridDim.x * gridDim.y * gridDim.z;
    unsigned sum, cnt, mine, sp = 0u;
    for (;;) {
        sum = 0u; cnt = 0u; mine = 0u;
#pragma unroll
        for (unsigned j = 0; j < 16; ++j) { const unsigned c = xb_ld(&bar[XB_XCNT(j)]); sum += c; cnt += (c > 0u) ? 1u : 0u; mine = (j == x) ? c : mine; }
        if (sum == G) break;
        __builtin_amdgcn_s_sleep(1);
        if ((++sp & 255u) == 0u) { if (xb_ld(&bar[XB_TMO])) break; if (sp > XB_SPIN_CAP) { atomicAdd(&bar[XB_TMO], 1u); break; } }
    }
    nloc = mine > 0u ? mine : 1u; nx = cnt > 0u ? cnt : 1u;
}
__device__ __forceinline__ void xcd_barrier(const XcdBarrier& b, bool leader) {
    asm volatile("s_waitcnt vmcnt(0)" ::: "memory");
    __syncthreads();
    if (leader) {
        unsigned* bar = b.bar;
        __builtin_amdgcn_s_waitcnt(0);
        unsigned nloc = b.st[0], nx = b.st[1];
        if (nloc == 0u) { xcd_barrier_complete(bar, b.x, nloc, nx); b.st[0] = nloc; b.st[1] = nx; }
        const unsigned old = xb_add(&bar[XB_XSUB(b.x)], 1u);
        const unsigned gen = old / nloc;
        if (old + 1u == (gen + 1u) * nloc) {
            __builtin_amdgcn_fence(__ATOMIC_RELEASE, "agent");
            asm volatile("s_waitcnt vmcnt(0)" ::: "memory");
            const unsigned og = xb_add(&bar[XB_TOP], 1u);
            const unsigned tg = og / nx;
            if (og + 1u == (tg + 1u) * nx) xb_add(&bar[XB_TOPGEN], 1u);
            else XB_SPIN(xb_ld(&bar[XB_TOPGEN]) == tg, bar);
            __builtin_amdgcn_fence(__ATOMIC_ACQUIRE, "agent");
            xb_add(&bar[XB_XGEN(b.x)], 1u);
            asm volatile("s_waitcnt vmcnt(0)" ::: "memory");
        } else {
            XB_SPIN(xb_ld(&bar[XB_XGEN(b.x)]) == gen, bar);
            __builtin_amdgcn_fence(__ATOMIC_ACQUIRE, "agent");
            asm volatile("s_waitcnt vmcnt(0)" ::: "memory");
        }
    }
    __syncthreads();
}
__device__ __forceinline__ void group_barrier(unsigned* bar, unsigned mism, bool leader) {
    asm volatile("s_waitcnt vmcnt(0)" ::: "memory");
    __syncthreads();
    if (leader) {
        __builtin_amdgcn_s_waitcnt(0);
        if (mism) { __builtin_amdgcn_fence(__ATOMIC_RELEASE, "agent"); asm volatile("s_waitcnt vmcnt(0)" ::: "memory"); }
        const unsigned xl = blockIdx.x & 7u;
        const unsigned old = xb_add(&bar[XB_LSUB(xl)], 1u);
        const unsigned gen = old >> 5;
        if ((old & 31u) == 31u) xb_add(&bar[XB_LGEN(xl)], 1u);
        else XB_SPIN(xb_ld(&bar[XB_LGEN(xl)]) == gen, bar);
        __builtin_amdgcn_fence(__ATOMIC_ACQUIRE, "agent");
        asm volatile("s_waitcnt vmcnt(0)" ::: "memory");
    }
    __syncthreads();
}

struct Args { const float* in[20]; float* out; unsigned char* ws; };
struct Frame {
    LAS unsigned char* lds;
    int tid, lane, wave, G, gw, NGW;
    unsigned char* ws;
};
#define MAKE_FRAME() Frame F; { F.lds = (LAS unsigned char*)lds_raw; F.wave = wave_id; F.lane = lane_id(); F.tid = wave_id * 64 + F.lane; \
    F.G = gridDim.x; F.gw = blockIdx.x * NWAVES + F.wave; F.NGW = F.G * NWAVES; F.ws = ws; }
__device__ __forceinline__ float wave_sum(float v) { return xq_sum(row_sum(v)); }
__device__ __forceinline__ float wave_max(float v) { return xq_max(row_max(v)); }

__device__ __forceinline__ int map_in(int j) {
    if (j < 896) return j;
    if (j < 960) return 1152 + (j - 896);
    if (j < 964) return 1216 + (j - 960);
    if (j < 1024) return -1;
    if (j < 1280) return 896 + (j - 1024);
    return 1220 + (j - 1280);
}
__device__ __forceinline__ int map_ffi(int r) { const int t = r >> 8, j = r & 255; return j < 128 ? t * 128 + j : D_FF + t * 128 + (j - 128); }
template <int MAP>
__device__ __forceinline__ void quant_cols_unit(const float* W, int N, const float* gain, unsigned char* W8, float* sw, int n0, LAS unsigned char* lds, int wave, int lane) {
    constexpr int P = 1028;
    LAS float* T = (LAS float*)lds; LAS unsigned* cmax = (LAS unsigned*)(lds + 32 * P * 4);
    const int n = lane & 31, par = lane >> 5, a = (n >> 3) & 3;
    const int src = MAP == 1 ? map_in(n0 + n) : map_ffi(n0 + n); const int srcc = src >= 0 ? src : 0;
    __syncthreads();
    if (wave == 0 && lane < 32) cmax[lane] = 0u;
    __syncthreads();
    float mx = 0.f;
#pragma unroll 1
    for (int b = 0; b < 4; ++b) {
        float vv[16], gg[16];
#pragma unroll
        for (int i = 0; i < 16; ++i) { const int k = 128 * wave + 32 * b + 2 * i + par; vv[i] = W[(size_t)k * N + srcc]; gg[i] = gain[k]; }
        __builtin_amdgcn_sched_barrier(0);
#pragma unroll
        for (int i = 0; i < 16; ++i) { const int k = 128 * wave + 32 * b + 2 * i + par; const float v = src >= 0 ? vv[i] * gg[i] : 0.f; mx = fmaxf(mx, fabsf(v)); T[n * P + (k ^ a)] = v; }
    }
    __hip_atomic_fetch_max(cmax + n, __float_as_uint(mx), __ATOMIC_RELAXED, __HIP_MEMORY_SCOPE_WORKGROUP);
    __syncthreads();
#pragma unroll
    for (int r = 0; r < 4; ++r) { const int nr = wave + 8 * r;
        const float m = __uint_as_float(cmax[nr]); const float inv = m > 0.f ? 127.0f / m : 0.f;
#pragma unroll
        for (int i = 0; i < 4; ++i) { const f32x4 v = *(const LAS f32x4*)(T + nr * P + 4 * lane + 256 * i);
            float e0 = v[0], e1 = v[1], e2 = v[2], e3 = v[3];
            if (r & 1) { float t_ = e0; e0 = e1; e1 = t_; t_ = e2; e2 = e3; e3 = t_; }
            if (r & 2) { float t_ = e0; e0 = e2; e2 = t_; t_ = e1; e1 = e3; e3 = t_; }
            const int q0 = (int)__builtin_rintf(e0 * inv), q1 = (int)__builtin_rintf(e1 * inv), q2 = (int)__builtin_rintf(e2 * inv), q3 = (int)__builtin_rintf(e3 * inv);
            *(unsigned*)(W8 + (size_t)(n0 + nr) * 1024 + 4 * lane + 256 * i) = (unsigned)(q0 & 255) | ((unsigned)(q1 & 255) << 8) | ((unsigned)(q2 & 255) << 16) | ((unsigned)(q3 & 255) << 24); }
        if (lane == 0) sw[n0 + nr] = m * (1.0f / 127.0f); }
}
template <int MAP, bool F8 = false>
__device__ __forceinline__ void transpose_item(const float* W, int K, int N, int NT, const float* gain, bf16_t* WT, LAS float* scr, int item, int lane, unsigned* wmax = nullptr) {
    const int nblk = NT / 32, kb = item / nblk, nb = item % nblk, k0 = 64 * kb, n0 = 32 * nb;
    const int nn = n0 + (lane & 31);
    const int src = MAP == 0 ? nn : (MAP == 1 ? map_in(nn) : map_ffi(nn));
    const int srcc = src >= 0 ? src : 0;
#pragma unroll
    for (int hf = 0; hf < 2; ++hf) {
        float vv_[16], gg_[16];
#pragma unroll
        for (int i = 0; i < 16; ++i) { const int kk = 2 * (16 * hf + i) + (lane >> 5); vv_[i] = W[(size_t)(k0 + kk) * N + srcc]; gg_[i] = gain ? gain[k0 + kk] : 1.f; }
        __builtin_amdgcn_sched_barrier(0);
#pragma unroll
        for (int i = 0; i < 16; ++i) { const int kk = 2 * (16 * hf + i) + (lane >> 5); scr[kk * 33 + (lane & 31)] = src >= 0 ? vv_[i] * gg_[i] : 0.f; }
        if (wmax) { float mx_ = 0.f;
#pragma unroll
            for (int i = 0; i < 16; ++i) mx_ = fmaxf(mx_, fabsf(vv_[i] * gg_[i]));
            atomicMax(wmax + nn, __float_as_uint(src >= 0 ? mx_ : 0.f)); }
    }
    LDS_WAIT();
    const int c = lane & 7;
#pragma unroll
    for (int j = 0; j < 4; ++j) { const int n = (lane >> 3) + 8 * j; const LAS float* s = scr + (8 * c) * 33 + n;
        if constexpr (F8) { u32x2 o8; o8.x = pk4_f8(s[0 * 33] * F8_WS, s[1 * 33] * F8_WS, s[2 * 33] * F8_WS, s[3 * 33] * F8_WS); o8.y = pk4_f8(s[4 * 33] * F8_WS, s[5 * 33] * F8_WS, s[6 * 33] * F8_WS, s[7 * 33] * F8_WS);
            *(u32x2*)((unsigned char*)WT + (size_t)(n0 + n) * K + k0 + 8 * c) = o8; }
        else { u32x4 o; o.x = pk2(s[0 * 33], s[1 * 33]); o.y = pk2(s[2 * 33], s[3 * 33]); o.z = pk2(s[4 * 33], s[5 * 33]); o.w = pk2(s[6 * 33], s[7 * 33]);
        *(u32x4*)(WT + (size_t)(n0 + n) * K + k0 + 8 * c) = o; } }
    LDS_WAIT();
}

__device__ __forceinline__ float gelu_tanh(float y) {
    const float t = 0.7978845608028654f * (y + 0.044715f * y * y * y);
    const float e = __expf(2.0f * t);
    const float th = 1.0f - 2.0f / (e + 1.0f);
    return 0.5f * y * (1.0f + th);
}

__device__ __forceinline__ void s5_expand(const Frame& F, const Args& a, int l, int slot, int ntot) {
    const float* tab = (const float*)(F.ws + WS_TAB);
    const float* POW = tab + TB_POW / 4 + (size_t)l * S5_G * S5_N * 65 * 2;
    const float* KC = tab + TB_KC / 4 + (size_t)l * S5_G * 64 * 256;
    const float* BB = tab + TB_S5BB / 4 + (size_t)l * S5_G * S5_N * 32;
    const float* CC = tab + TB_S5C / 4 + (size_t)l * S5_G * S5_N * 32;
    bf16_t* M = (bf16_t*)(F.ws + WS_S5M); bf16_t* W = (bf16_t*)(F.ws + WS_S5W);
    const int gt = slot * (NWAVES * 64) + F.wave * 64 + lane_id(), NT = ntot * NWAVES * 64;
    for (int i = gt; i < S5_G * 16 * 128 * 2; i += NT) {
        const int qh = i & 1, e = (i >> 1) & 127, p = (i >> 8) & 15, g = i >> 12;
        float v[8];
        if (e <= 63) { const float* kp = KC + ((size_t)(g * 64 + (63 - e)) * 16 + p) * 16 + 8 * qh; const f32x4 k0 = *(const f32x4*)kp, k1 = *(const f32x4*)(kp + 4);
            v[0] = k0[0]; v[1] = k0[1]; v[2] = k0[2]; v[3] = k0[3]; v[4] = k1[0]; v[5] = k1[1]; v[6] = k1[2]; v[7] = k1[3];
            if (e == 63 && (p >> 3) == qh) { const float dsk = a.in[11][(size_t)(l * S5_G + g) * S5_P + p];
#pragma unroll
                for (int j = 0; j < 8; ++j) v[j] += ((p & 7) == j) ? dsk : 0.f; } }
        else {
#pragma unroll
            for (int j = 0; j < 8; ++j) v[j] = 0.f; }
        u32x4 o; o.x = pk2(v[0], v[1]); o.y = pk2(v[2], v[3]); o.z = pk2(v[4], v[5]); o.w = pk2(v[6], v[7]);
        *(u32x4*)(M + ((size_t)(g * 16 + p) * 128 + e) * 16 + 8 * qh) = o;
    }
    for (int i = gt; i < S5_G * 1024 * 16; i += NT) {
        const int cks = i & 15, row = (i >> 4) & 1023, g = i >> 14, tau = row >> 4, p = row & 15; const bool im = cks >= 8; const int n0 = (cks & 7) * 8;
        float v[8];
#pragma unroll
        for (int j = 0; j < 8; ++j) { const int n = n0 + j; const float* pw = POW + ((size_t)(g * S5_N + n) * 65 + (tau + 1)) * 2; const float* cp = CC + ((size_t)(g * S5_N + n) * 16 + p) * 2;
            const float pr = pw[0], pi = pw[1], cr = cp[0], ci = cp[1];
            v[j] = im ? -(cr * pi + ci * pr) : (cr * pr - ci * pi); }
        u32x4 o; o.x = pk2(v[0], v[1]); o.y = pk2(v[2], v[3]); o.z = pk2(v[4], v[5]); o.w = pk2(v[6], v[7]);
        *(u32x4*)(M + S5_KR_ELEMS + ((size_t)g * 1024 + row) * 128 + cks * 8) = o;
    }
    for (int i = gt; i < S5_G * 256 * 128; i += NT) {
        const int ck = i & 127, row = (i >> 7) & 255, g = i >> 15, sg = ck >> 1, q0 = (ck & 1) * 8;
        float v[8];
        if (row < 128) { const int n = row & 63; const bool im = row >= 64;
            const float* pw = POW + ((size_t)(g * S5_N + n) * 65 + (63 - sg)) * 2; const float pr = pw[0], pi = pw[1];
            const float* bp = BB + ((size_t)(g * S5_N + n) * 16 + q0) * 2;
#pragma unroll
            for (int j = 0; j < 8; ++j) { const float br = bp[2 * j], bi = bp[2 * j + 1]; v[j] = im ? (pr * bi + pi * br) : (pr * br - pi * bi); } }
        else {
#pragma unroll
            for (int j = 0; j < 8; ++j) v[j] = 0.f; }
        u32x4 o; o.x = pk2(v[0], v[1]); o.y = pk2(v[2], v[3]); o.z = pk2(v[4], v[5]); o.w = pk2(v[6], v[7]);
        *(u32x4*)(W + ((size_t)g * 256 + row) * 1024 + ck * 8) = o;
    }
}
__device__ __forceinline__ void s5_unit(unsigned char* ws_, int wave_id, int l, int g, int mh) {
    extern __shared__ __attribute__((aligned(16))) unsigned char lds_raw[];
    g = __builtin_amdgcn_readfirstlane(g); mh = __builtin_amdgcn_readfirstlane(mh); asm volatile("" : "+s"(g), "+s"(mh));
    unsigned char* ws = ws_; MAKE_FRAME();
    bf16_t* U = (bf16_t*)(F.ws + WS_S5U) + (size_t)g * 512 * S5K;
    const bf16_t* W = (const bf16_t*)(F.ws + WS_S5W) + (size_t)g * 256 * 1024;
    const bf16_t* KR = (const bf16_t*)(F.ws + WS_S5M) + (size_t)g * 16 * 128 * 16; const bf16_t* B2 = (const bf16_t*)(F.ws + WS_S5M) + S5_KR_ELEMS + (size_t)g * 1024 * 128;
    float* E = (float*)(F.ws + WS_S5E) + (size_t)blockIdx.x * 256 * 128;
    {   pg8::Gemm gm{U, W, S5K, 1024, 1024}; pg8::SingleUnit S{mh, 0}; pg8::EpiS5State Ep{E};
        pg8::gemm_phase<pg8::EpiS5State, pg8::SingleUnit, false, true>(F.lds, gm, S, Ep, F.wave); }
    __syncthreads();
    const int tid2 = wave_id * 64 + lane_id();
    if (tid2 < 256) {
        const int bl = tid2 >> 6, n = tid2 & 63;
        const float* pw = (const float*)(F.ws + WS_TAB) + TB_POW / 4 + ((size_t)((l * S5_G + g) * S5_N + n) * 65 + 64) * 2;
        const float lr = pw[0], li = pw[1];
        float hr = 0.f, hi = 0.f;
        for (int c0 = 0; c0 < 64; c0 += 16) {
            float er[16], ei[16];
#pragma unroll
            for (int j = 0; j < 16; ++j) { const int r = bl * 64 + c0 + j; er[j] = E[(size_t)r * 128 + n]; ei[j] = E[(size_t)r * 128 + 64 + n]; }
#pragma unroll
            for (int j = 0; j < 16; ++j) {
                const int r = bl * 64 + c0 + j;
                bf16_t* up = U + (size_t)(mh * 256 + r) * S5K + 1024;
                up[n] = (bf16_t)f2bf(hr); up[64 + n] = (bf16_t)f2bf(hi);
                const float nr = lr * hr - li * hi + er[j], ni = lr * hi + li * hr + ei[j];
                hr = nr; hi = ni;
            }
        }
    }
    VM_WAIT();
    __syncthreads();
    {   pg8::Gemm gm{U, KR, S5K, 0, S5K, B2}; pg8::RowUnits S{mh, 4}; pg8::EpiS5Y Ep{(bf16_t*)(F.ws + WS_YG), g};
        pg8::gemm_phase<pg8::EpiS5Y, pg8::RowUnits, true, true, 1>(F.lds, gm, S, Ep, F.wave); }
}

typedef short s16x4 __attribute__((ext_vector_type(4)));
constexpr int RT_Q = 0, RT_KA = 16384, RT_KB = 32768, RT_V = 49152, RT_S = 65536;
__device__ __forceinline__ s16x4 tr_rd(LAS unsigned char* p) { return __builtin_bit_cast(s16x4, __builtin_amdgcn_ds_read_tr16_b64_v4i16((LAS s16x4*)p)); }
__device__ __forceinline__ int swzA(int row, int colb) { return row * 128 + (colb ^ ((row & 7) << 4)); }
__device__ __forceinline__ int swzB(int row, int colb) { return row * 128 + (colb ^ (((row >> 1) & 3) << 5)); }
__device__ __forceinline__ void ret_unit(unsigned char* ws_, int wave_id, const float* gn, int l, int b, int h) {
    extern __shared__ __attribute__((aligned(16))) unsigned char lds_raw[];
    b = __builtin_amdgcn_readfirstlane(b); h = __builtin_amdgcn_readfirstlane(h); asm volatile("" : "+s"(b), "+s"(h));
    unsigned char* ws = ws_; MAKE_FRAME();
    const int tid = F.tid, lane = F.lane, w = F.wave, fr = lane & 15, fq = lane >> 4;
    LAS unsigned char* L = F.lds;
    const bf16_t* proj = (const bf16_t*)(F.ws + WS_PROJ);
    bf16_t* mix = (bf16_t*)(F.ws + WS_MIX);
    const float* rope = (const float*)(F.ws + WS_TAB + TB_ROPE);
    const float gamma = 1.0f - exp2f(-5.0f - (float)h), lg2 = log2f(gamma);
    const float g127 = exp2f(127.0f * lg2), g128 = g127 * gamma;
    const int trow = (tid & 255) >> 1, tp = tid & 1; const bool isk = tid >= 256;
    const int vrow = tid >> 2, vpart = tid & 3;
    const size_t colqk = (size_t)(isk ? PC_RK : PC_RQ) + h * 64 + 16 * tp;
    f32x4 sacc[2];
    sacc[0] = (f32x4){0.f, 0.f, 0.f, 0.f}; sacc[1] = sacc[0];
    for (int i = tid; i < 8192 / 4; i += NWAVES * 64) ((LAS unsigned*)(L + RT_S))[i] = 0u;
    u32x4 rq[4], rv[2];
    {   const bf16_t* p0 = proj + (size_t)(b * SEQ + trow) * NPROJ + colqk;
        rq[0] = *(const u32x4*)p0; rq[1] = *(const u32x4*)(p0 + 8); rq[2] = *(const u32x4*)(p0 + 32); rq[3] = *(const u32x4*)(p0 + 40);
        const bf16_t* pv = proj + (size_t)(b * SEQ + vrow) * NPROJ + PC_RV + h * 64 + 16 * vpart;
        rv[0] = *(const u32x4*)pv; rv[1] = *(const u32x4*)(pv + 8); }
    for (int c = 0; c < SEQ / 128; ++c) {
        {
            const int pos = c * 128 + trow;
            const float sc = isk ? exp2f(-(float)trow * lg2) * 0.125f : exp2f((float)trow * lg2);
            const float* rp = rope + ((size_t)pos * 32 + 16 * tp) * 2;
            float x1[16], x2[16];
            const unsigned wa[8] = {rq[0].x, rq[0].y, rq[0].z, rq[0].w, rq[1].x, rq[1].y, rq[1].z, rq[1].w};
            const unsigned wb[8] = {rq[2].x, rq[2].y, rq[2].z, rq[2].w, rq[3].x, rq[3].y, rq[3].z, rq[3].w};
#pragma unroll
            for (int i = 0; i < 8; ++i) { x1[2 * i] = bflo(wa[i]); x1[2 * i + 1] = bfhi(wa[i]); x2[2 * i] = bflo(wb[i]); x2[2 * i + 1] = bfhi(wb[i]); }
            unsigned o1[8], o2[8];
#pragma unroll
            for (int i = 0; i < 8; ++i) {
                const f32x4 cs = *(const f32x4*)(rp + 4 * i);
                const float a0 = (x1[2 * i] * cs[0] - x2[2 * i] * cs[1]) * sc, a1 = (x1[2 * i + 1] * cs[2] - x2[2 * i + 1] * cs[3]) * sc;
                const float b0 = (x2[2 * i] * cs[0] + x1[2 * i] * cs[1]) * sc, b1 = (x2[2 * i + 1] * cs[2] + x1[2 * i + 1] * cs[3]) * sc;
                o1[i] = pk2(a0, a1); o2[i] = pk2(b0, b1); }
            const u32x4 p0 = {o1[0], o1[1], o1[2], o1[3]}, p1 = {o1[4], o1[5], o1[6], o1[7]}, p2 = {o2[0], o2[1], o2[2], o2[3]}, p3 = {o2[4], o2[5], o2[6], o2[7]};
            const int cb = 32 * tp;
            if (!isk) {
                *(LAS u32x4*)(L + RT_Q + swzA(trow, cb)) = p0; *(LAS u32x4*)(L + RT_Q + swzA(trow, cb + 16)) = p1;
                *(LAS u32x4*)(L + RT_Q + swzA(trow, cb + 64)) = p2; *(LAS u32x4*)(L + RT_Q + swzA(trow, cb + 80)) = p3;
            } else {
                *(LAS u32x4*)(L + RT_KA + swzA(trow, cb)) = p0; *(LAS u32x4*)(L + RT_KA + swzA(trow, cb + 16)) = p1;
                *(LAS u32x4*)(L + RT_KA + swzA(trow, cb + 64)) = p2; *(LAS u32x4*)(L + RT_KA + swzA(trow, cb + 80)) = p3;
                *(LAS u32x4*)(L + RT_KB + swzB(trow, cb)) = p0; *(LAS u32x4*)(L + RT_KB + swzB(trow, cb + 16)) = p1;
                *(LAS u32x4*)(L + RT_KB + swzB(trow, cb + 64)) = p2; *(LAS u32x4*)(L + RT_KB + swzB(trow, cb + 80)) = p3;
            }
            *(LAS u32x4*)(L + RT_V + swzB(vrow, 32 * vpart)) = rv[0]; *(LAS u32x4*)(L + RT_V + swzB(vrow, 32 * vpart + 16)) = rv[1];
        }
        __syncthreads();
        if (c + 1 < SEQ / 128) {
            const bf16_t* p0 = proj + (size_t)(b * SEQ + (c + 1) * 128 + trow) * NPROJ + colqk;
            rq[0] = *(const u32x4*)p0; rq[1] = *(const u32x4*)(p0 + 8); rq[2] = *(const u32x4*)(p0 + 32); rq[3] = *(const u32x4*)(p0 + 40);
            const bf16_t* pv = proj + (size_t)(b * SEQ + (c + 1) * 128 + vrow) * NPROJ + PC_RV + h * 64 + 16 * vpart;
            rv[0] = *(const u32x4*)pv; rv[1] = *(const u32x4*)(pv + 8); }
        const size_t tok = (size_t)b * SEQ + c * 128 + 16 * w + fr;
        u32x2 gv[4];
#pragma unroll
        for (int et = 0; et < 4; ++et) gv[et] = *(const u32x2*)(proj + tok * NPROJ + PC_RG + h * 64 + 16 * et + 4 * fq);
        bf16x8 qf[2];
#pragma unroll
        for (int ks = 0; ks < 2; ++ks) qf[ks] = *(const LAS bf16x8*)(L + RT_Q + swzA(16 * w + fr, 16 * fq + 64 * ks));
        f32x4 accO[4], accX[4];
#pragma unroll
        for (int et = 0; et < 4; ++et) { accO[et] = (f32x4){0.f, 0.f, 0.f, 0.f}; accX[et] = accO[et]; }
        const int npair = (w + 2) >> 1;
        for (int pr = 0; pr < npair; ++pr) {
            const int T0 = 2 * pr, T1 = 2 * pr + 1;
            f32x4 s0 = (f32x4){0.f, 0.f, 0.f, 0.f}, s1 = s0;
#pragma unroll
            for (int ks = 0; ks < 2; ++ks) {
                const bf16x8 k0 = *(const LAS bf16x8*)(L + RT_KA + swzA(16 * T0 + fr, 16 * fq + 64 * ks));
                const bf16x8 k1 = *(const LAS bf16x8*)(L + RT_KA + swzA(16 * T1 + fr, 16 * fq + 64 * ks));
                s0 = __builtin_amdgcn_mfma_f32_16x16x32_bf16(k0, qf[ks], s0, 0, 0, 0);
                s1 = __builtin_amdgcn_mfma_f32_16x16x32_bf16(k1, qf[ks], s1, 0, 0, 0);
            }
#pragma unroll
            for (int r = 0; r < 4; ++r) {
                const bool k0ok = (T0 < w) || (T0 == w && 4 * fq + r <= fr);
                const bool k1ok = (T1 < w) || (T1 == w && 4 * fq + r <= fr);
                s0[r] = k0ok ? s0[r] : 0.f; s1[r] = k1ok ? s1[r] : 0.f; }
            u32x4 pw; pw.x = pk2(s0[0], s0[1]); pw.y = pk2(s0[2], s0[3]); pw.z = pk2(s1[0], s1[1]); pw.w = pk2(s1[2], s1[3]);
            const bf16x8 pb = __builtin_bit_cast(bf16x8, pw);
#pragma unroll
            for (int et = 0; et < 4; ++et) {
                const s16x4 v0 = tr_rd(L + RT_V + swzB(16 * T0 + 4 * fq + (fr >> 2), 32 * et + 8 * (fr & 3)));
                const s16x4 v1 = tr_rd(L + RT_V + swzB(16 * T1 + 4 * fq + (fr >> 2), 32 * et + 8 * (fr & 3)));
                const bf16x8 va = __builtin_shufflevector(v0, v1, 0, 1, 2, 3, 4, 5, 6, 7);
                accO[et] = __builtin_amdgcn_mfma_f32_16x16x32_bf16(va, pb, accO[et], 0, 0, 0);
            }
        }
#pragma unroll
        for (int et = 0; et < 4; ++et)
#pragma unroll
            for (int ks = 0; ks < 2; ++ks) {
                const bf16x8 sf = *(const LAS bf16x8*)(L + RT_S + swzA(16 * et + fr, 16 * fq + 64 * ks));
                accX[et] = __builtin_amdgcn_mfma_f32_16x16x32_bf16(sf, qf[ks], accX[et], 0, 0, 0);
            }
        f32x4 tmp[2];
#pragma unroll
        for (int x = 0; x < 2; ++x) {
            const int tt = 2 * w + x, et = tt >> 2, dt = tt & 3;
            tmp[x] = (f32x4){0.f, 0.f, 0.f, 0.f};
#pragma unroll
            for (int ks = 0; ks < 4; ++ks) {
                const int j0 = 32 * ks + 4 * fq + (fr >> 2), j1 = j0 + 16;
                const s16x4 v0 = tr_rd(L + RT_V + swzB(j0, 32 * et + 8 * (fr & 3))), v1 = tr_rd(L + RT_V + swzB(j1, 32 * et + 8 * (fr & 3)));
                const s16x4 k0 = tr_rd(L + RT_KB + swzB(j0, 32 * dt + 8 * (fr & 3))), k1 = tr_rd(L + RT_KB + swzB(j1, 32 * dt + 8 * (fr & 3)));
                const bf16x8 va = __builtin_shufflevector(v0, v1, 0, 1, 2, 3, 4, 5, 6, 7), kb = __builtin_shufflevector(k0, k1, 0, 1, 2, 3, 4, 5, 6, 7);
                tmp[x] = __builtin_amdgcn_mfma_f32_16x16x32_bf16(va, kb, tmp[x], 0, 0, 0);
            }
            sacc[x] = sacc[x] * g128 + tmp[x] * g127;
        }
        __syncthreads();
#pragma unroll
        for (int x = 0; x < 2; ++x) { const int tt = 2 * w + x, et = tt >> 2, dt = tt & 3;
#pragma unroll
            for (int r = 0; r < 4; ++r) { const int e = 16 * et + 4 * fq + r, d = 16 * dt + fr;
                *(LAS unsigned short*)(L + RT_S + swzA(e, 2 * d)) = (unsigned short)f2bf(sacc[x][r]); } }
        float o[16]; float s = 0.f;
#pragma unroll
        for (int et = 0; et < 4; ++et)
#pragma unroll
            for (int r = 0; r < 4; ++r) { o[4 * et + r] = accO[et][r] + gamma * accX[et][r]; s += o[4 * et + r]; }
        s = xq_sum(s);
        const float mu = s * (1.0f / 64.0f); float q2 = 0.f;
#pragma unroll
        for (int i = 0; i < 16; ++i) { o[i] -= mu; q2 += o[i] * o[i]; }
        q2 = xq_sum(q2);
        const float rstd = 1.0f / sqrtf(q2 * (1.0f / 64.0f) + GN_EPS);
#pragma unroll
        for (int et = 0; et < 4; ++et) {
            const f32x4 gw = *(const f32x4*)(gn + (size_t)l * 256 + h * 64 + 16 * et + 4 * fq);
            const float g0 = bflo(gv[et].x), g1 = bfhi(gv[et].x), g2 = bflo(gv[et].y), g3 = bfhi(gv[et].y);
            const float y0 = g0 / (1.0f + __expf(-g0)) * o[4 * et] * rstd * gw[0], y1 = g1 / (1.0f + __expf(-g1)) * o[4 * et + 1] * rstd * gw[1];
            const float y2 = g2 / (1.0f + __expf(-g2)) * o[4 * et + 2] * rstd * gw[2], y3 = g3 / (1.0f + __expf(-g3)) * o[4 * et + 3] * rstd * gw[3];
            u32x2 ow; ow.x = pk2(y0, y1); ow.y = pk2(y2, y3);
            *(u32x2*)(mix + tok * 1024 + 768 + h * 64 + 16 * et + 4 * fq) = ow;
        }
    }
    __syncthreads();
}

__device__ __forceinline__ void glds16(const void* gsrc, unsigned lds_dst) {
    unsigned keep;
    asm volatile("s_mov_b32 %0, m0\n\ts_mov_b32 m0, %2\n\ts_nop 0\n\tglobal_load_lds_dwordx4 %1, off\n\ts_mov_b32 m0, %0" : "=&s"(keep) : "v"(gsrc), "s"(lds_dst) : "memory");
}
__device__ __forceinline__ void glds4(const void* gsrc, unsigned lds_dst) {
    unsigned keep;
    asm volatile("s_mov_b32 %0, m0\n\ts_mov_b32 m0, %2\n\ts_nop 0\n\tglobal_load_lds_dword %1, off\n\ts_mov_b32 m0, %0" : "=&s"(keep) : "v"(gsrc), "s"(lds_dst) : "memory");
}
__device__ __forceinline__ unsigned fkey(float f) { const unsigned u = __builtin_bit_cast(unsigned, f); return (u & 0x80000000u) ? ~u : (u | 0x80000000u); }
constexpr int DS_KBUF = 0, DS_HIST = 32768, DS_TIE = 32768, DS_VST1 = 65536, DS_CAND = 65536, DS_BITS = 98304, DS_WMISC = 131072, DS_LUT = 139264, DS_THR = 143360, DS_RED = 144384;
constexpr int DW_LIST = 0, DW_PFX = 512, DW_SCR = 768;
struct DsaQ {
    bf16x8 Bq[4][2];
    float lo[4], hi[4];
    float inv; int ZB;
};
__device__ __forceinline__ void dsa_build_q(DsaQ& Q, const bf16_t* proj, const bf16_t* kvb, size_t tok, int fq, float krms) {
    asm volatile("" : "+v"(fq));
    const bf16_t* prow = proj + tok * NPROJ;
    const u32x2 wv = *(const u32x2*)(kvb + tok * KV_LD + KV_IW);
    const float wh[4] = {bflo(wv.x) * 0.0625f, bfhi(wv.x) * 0.0625f, bflo(wv.y) * 0.0625f, bfhi(wv.y) * 0.0625f};
    float hi_sum = 0.f, lo_sum = 0.f;
#pragma unroll
    for (int h = 0; h < 4; ++h) {
        float sq = 0.f;
#pragma unroll
        for (int ks = 0; ks < 2; ++ks) {
            const u32x4 v = *(const u32x4*)(prow + PC_IQ + h * 64 + 8 * fq + 32 * ks);
            const unsigned w4[4] = {v.x, v.y, v.z, v.w};
#pragma unroll
            for (int j = 0; j < 4; ++j) { const float a = bflo(w4[j]), c = bfhi(w4[j]); sq += a * a + c * c; }
        }
        sq = xq_sum(sq);
        const float rng = fabsf(wh[h]) * sqrtf(sq) * krms * 3.0f;
        const bool pos = wh[h] > 0.f;
        Q.lo[h] = pos ? 0.f : -__builtin_inff(); Q.hi[h] = pos ? __builtin_inff() : 0.f;
        if (pos) hi_sum += rng; else lo_sum += rng;
    }
    const float R = fmaxf(hi_sum, lo_sum);
    const float inv = R > 0.f ? 16129.0f / R : 0.f;
#pragma unroll
    for (int h = 0; h < 4; ++h) { const float sc = wh[h] * inv;
#pragma unroll
        for (int ks = 0; ks < 2; ++ks) {
            const u32x4 v = *(const u32x4*)(prow + PC_IQ + h * 64 + 8 * fq + 32 * ks);
            const unsigned w4[4] = {v.x, v.y, v.z, v.w}; unsigned o4[4];
#pragma unroll
            for (int j = 0; j < 4; ++j) o4[j] = pk2(bflo(w4[j]) * sc, bfhi(w4[j]) * sc);
            const u32x4 ov = {o4[0], o4[1], o4[2], o4[3]};
            Q.Bq[h][ks] = __builtin_bit_cast(bf16x8, ov);
        }
    }
    Q.inv = 1.0f;
    Q.ZB = 128;
}
__device__ __forceinline__ float dsa_score_raw(const DsaQ& Q, const f32x4 (&acc)[4], int r) {
    return (__builtin_amdgcn_fmed3f(acc[0][r], Q.lo[0], Q.hi[0]) + __builtin_amdgcn_fmed3f(acc[1][r], Q.lo[1], Q.hi[1])) + (__builtin_amdgcn_fmed3f(acc[2][r], Q.lo[2], Q.hi[2]) + __builtin_amdgcn_fmed3f(acc[3][r], Q.lo[3], Q.hi[3]));
}
__device__ __forceinline__ unsigned pk_h2(float a, float b) { return __builtin_bit_cast(unsigned, __builtin_amdgcn_cvt_pkrtz(a, b)); }
__device__ __forceinline__ float h16f(unsigned bits) { return (float)__builtin_bit_cast(_Float16, (unsigned short)bits); }
__device__ __forceinline__ float dsa_score(const DsaQ& Q, const f32x4 (&acc)[4], int r) { return h16f(pk_h2(dsa_score_raw(Q, acc, r), 0.f) & 0xffffu); }
__device__ __forceinline__ float dsa_binf_inv(float inv, float s) {
    (void)inv;
    const float m = fminf(__builtin_ceilf(__builtin_amdgcn_sqrtf(fabsf(s))), 127.0f);
    return __builtin_copysignf(m, s);
}
__device__ __forceinline__ float dsa_binf(const DsaQ& Q, float s) {
    return dsa_binf_inv(Q.inv, s);
}
template <int MODE>
__device__ __forceinline__ void dsa_pass(LAS unsigned char* L, const bf16_t* ikb, int qb, int wave, int lane, const DsaQ& Q, int tq, int bstar, u32x2* sc) {
    const int fr = lane & 15, fq = lane >> 4, qg = wave & 3, kh = wave >> 2, qloc = 16 * qg + fr;
    const int ntile = (qb + 2) >> 1;
    const float bstarf = (float)(bstar - 128);
    const int drow = 8 * wave + (lane >> 3), dch = lane & 7;
    const size_t src0 = (size_t)drow * KV_LD * 2 + (size_t)((dch ^ (drow & 7)) * 16), src1 = src0 + (size_t)64 * KV_LD * 2;
    const unsigned kb_lds = (unsigned)__builtin_amdgcn_readfirstlane((int)(unsigned)(size_t)(L + DS_KBUF + wave * 1024));
#define DSA_STAGE(kt_, buf_) do { const char* tb_ = (const char*)ikb + (size_t)(kt_) * 128 * KV_LD * 2; \
        glds16(tb_ + src0, kb_lds + (buf_) * 16384); glds16(tb_ + src1, kb_lds + (buf_) * 16384 + 8192); } while (0)
    DSA_STAGE(0, 0);
    for (int kt = 0; kt < ntile; ++kt) {
        asm volatile("s_waitcnt vmcnt(0)" ::: "memory");
        __syncthreads();
        if (kt + 1 < ntile) DSA_STAGE(kt + 1, (kt + 1) & 1);
        LAS unsigned char* buf = L + DS_KBUF + (kt & 1) * 16384;
        const bool last = (kt == ntile - 1);
#define PASS_TILE(LASTT) \
        _Pragma("unroll 1") for (int si = 0; si < 4; ++si) { \
            const int sub = 2 * si + kh; \
            f32x4 acc[4]; \
            _Pragma("unroll") \
            for (int h = 0; h < 4; ++h) acc[h] = (f32x4){0.f, 0.f, 0.f, 0.f}; \
            _Pragma("unroll") \
            for (int ks = 0; ks < 2; ++ks) { \
                const bf16x8 a = *(const LAS bf16x8*)(buf + swzA(16 * sub + fr, 16 * fq + 64 * ks)); \
            _Pragma("unroll") \
                for (int h = 0; h < 4; ++h) acc[h] = __builtin_amdgcn_mfma_f32_16x16x32_bf16(a, Q.Bq[h][ks], acc[h], 0, 0, 0); \
            } \
            const int key0 = 128 * kt + 16 * sub + 4 * fq; \
            unsigned msel = 0u, mtie = 0u; \
            LAS unsigned* hq = (LAS unsigned*)(L + DS_HIST) + qloc * 256 + 128; \
            u32x2 pkv_; pkv_.x = pk_h2(dsa_score_raw(Q, acc, 0), dsa_score_raw(Q, acc, 1)); pkv_.y = pk_h2(dsa_score_raw(Q, acc, 2), dsa_score_raw(Q, acc, 3)); \
            if (MODE == 1) sc[(size_t)((kt * 8 + wave) * 4 + si) * 64 + lane] = pkv_; \
            float s4_[4] = {h16f(pkv_.x & 0xffffu), h16f(pkv_.x >> 16), h16f(pkv_.y & 0xffffu), h16f(pkv_.y >> 16)}; \
            asm volatile("" : "+v"(s4_[0]), "+v"(s4_[1]), "+v"(s4_[2]), "+v"(s4_[3]));       \
            _Pragma("unroll") \
            for (int r = 0; r < 4; ++r) { \
                const float s = s4_[r]; \
                const float bf = dsa_binf(Q, s); \
                const bool valid = !(LASTT) || (key0 + r <= tq); \
                if (MODE == 1) { __hip_atomic_fetch_add(hq + (int)bf, valid ? 1u : 0u, __ATOMIC_RELAXED, __HIP_MEMORY_SCOPE_WORKGROUP); } \
                else { msel |= (valid && bf > bstarf) ? (1u << r) : 0u; const bool tie = valid && bf == bstarf; mtie |= tie ? (1u << r) : 0u; \
                    if (tie) { \
                        const unsigned slot = __hip_atomic_fetch_add((LAS unsigned*)(L + DS_THR) + 4 * qloc + 3, 1u, __ATOMIC_RELAXED, __HIP_MEMORY_SCOPE_WORKGROUP); \
                        if (slot < 64u) { u32x2 e; e.x = fkey(s); e.y = (unsigned)(key0 + r); *((LAS u32x2*)(L + DS_CAND) + qloc * 64 + slot) = e; } } } \
            } \
            if (MODE == 2) { \
                const int wd = key0 >> 5, sh = key0 & 31; \
                if (msel) __hip_atomic_fetch_or((LAS unsigned*)(L + DS_BITS) + qloc * 128 + wd, msel << sh, __ATOMIC_RELAXED, __HIP_MEMORY_SCOPE_WORKGROUP); \
                if (mtie) __hip_atomic_fetch_or((LAS unsigned*)(L + DS_TIE) + qloc * 128 + wd, mtie << sh, __ATOMIC_RELAXED, __HIP_MEMORY_SCOPE_WORKGROUP); \
            } \
        }
        if (last) { PASS_TILE(true) } else { PASS_TILE(false) }
#undef PASS_TILE
    }
#undef DSA_STAGE
    __syncthreads();
}
__device__ __forceinline__ void dsa_pass2s(LAS unsigned char* L, const u32x2* sc, int qb, int wave, int lane, int tq, float shi, float slo) {
    const int fr = lane & 15, fq = lane >> 4, qg = wave & 3, kh = wave >> 2, qloc = 16 * qg + fr;
    const int ntile = (qb + 2) >> 1;
    const u32x2* sp = sc + (size_t)wave * 256 + lane;
    u32x2 cur[4], nxt[4];
#pragma unroll
    for (int si = 0; si < 4; ++si) { cur[si] = sp[si * 64]; nxt[si] = cur[si]; }
#pragma unroll 1
    for (int kt = 0; kt < ntile; ++kt) {
        if (kt + 1 < ntile) {
#pragma unroll
            for (int si = 0; si < 4; ++si) nxt[si] = sp[(size_t)(kt + 1) * 2048 + si * 64]; }
        __builtin_amdgcn_sched_barrier(0);
        const bool last = (kt == ntile - 1);
#pragma unroll
        for (int si = 0; si < 4; ++si) {
            const int key0 = 128 * kt + 16 * (2 * si + kh) + 4 * fq;
            const float s4[4] = {h16f(cur[si].x & 0xffffu), h16f(cur[si].x >> 16), h16f(cur[si].y & 0xffffu), h16f(cur[si].y >> 16)};
            unsigned msel = 0u, mtie = 0u;
#pragma unroll
            for (int r = 0; r < 4; ++r) {
                const float s = s4[r];
                const bool valid = !last || (key0 + r <= tq);
                const bool sel = valid && s >= shi, tie = valid && s >= slo && !(s >= shi);
                msel |= sel ? (1u << r) : 0u; mtie |= tie ? (1u << r) : 0u;
            }
            unsigned x = (msel | (mtie << 16)) << (4 * fq);
            { const u32x2v r1 = plswap16(__uint_as_float(x)); const unsigned a0 = r1[0], a1 = r1[1]; x = a0 | a1; }
            { const u32x2v r2 = plswap32(__uint_as_float(x)); const unsigned b0 = r2[0], b1 = r2[1]; x = b0 | b1; }
            if (fq == 0) { const int hw = qloc * 256 + 2 * (4 * kt + si) + kh;
                ((LAS unsigned short*)(L + DS_BITS))[hw] = (unsigned short)(x & 0xffffu); ((LAS unsigned short*)(L + DS_TIE))[hw] = (unsigned short)(x >> 16); }
        }
#pragma unroll
        for (int si = 0; si < 4; ++si) cur[si] = nxt[si];
    }
    asm volatile("s_waitcnt lgkmcnt(0)" ::: "memory");
    __syncthreads();
}
__device__ __forceinline__ float dsa_thr_score(float inv, float bstarf, bool strict) {
    unsigned lo = 0x03ffu, hi = 0xfc01u;
#pragma unroll 1
    for (int it = 0; it < 16; ++it) { const unsigned mid = (lo + hi) >> 1; const unsigned hb = (mid & 0x8000u) ? (mid & 0x7fffu) : (~mid & 0xffffu);
        const float bf = dsa_binf_inv(inv, h16f(hb)); const bool p = strict ? (bf > bstarf) : (bf >= bstarf);
        if (lo < hi) { if (p) hi = mid; else lo = mid + 1u; } }
    const unsigned hb = (lo & 0x8000u) ? (lo & 0x7fffu) : (~lo & 0xffffu);
    return lo >= 0xfc01u ? __builtin_nanf("") : h16f(hb);
}
__device__ __forceinline__ int wave_incl_scan(int v, int lane) {
    (void)lane;
    v += __builtin_amdgcn_update_dpp(0, v, 0x111, 0xf, 0xf, false);
    v += __builtin_amdgcn_update_dpp(0, v, 0x112, 0xf, 0xf, false);
    v += __builtin_amdgcn_update_dpp(0, v, 0x114, 0xf, 0xf, false);
    v += __builtin_amdgcn_update_dpp(0, v, 0x118, 0xf, 0xf, false);
    v += __builtin_amdgcn_update_dpp(0, v, 0x142, 0xa, 0xf, false);
    v += __builtin_amdgcn_update_dpp(0, v, 0x143, 0xc, 0xf, false);
    return v;
}
#define BITS_ENUM(W0, W1, LANE, TOTAL, BODY) do { \
    const int c_ = __builtin_popcount(W0) + __builtin_popcount(W1); \
    const int p_ = wave_incl_scan(c_, LANE); TOTAL = __builtin_amdgcn_readlane(p_, 63); \
    int pos = p_ - c_; \
    { unsigned w_ = (W0); while (w_) { const int bit_ = __builtin_ctz(w_); w_ &= w_ - 1u; const int key = 64 * (LANE) + bit_; BODY; ++pos; } } \
    { unsigned w_ = (W1); while (w_) { const int bit_ = __builtin_ctz(w_); w_ &= w_ - 1u; const int key = 64 * (LANE) + 32 + bit_; BODY; ++pos; } } } while (0)

__device__ __forceinline__ void dsa_qblock(unsigned char* ws_, int wave_id, int b, int qb, int half, u32x2* sc) {
    extern __shared__ __attribute__((aligned(16))) unsigned char lds_raw[];
    b = __builtin_amdgcn_readfirstlane(b); qb = __builtin_amdgcn_readfirstlane(qb); half = __builtin_amdgcn_readfirstlane(half); asm volatile("" : "+s"(b), "+s"(qb), "+s"(half));
    unsigned char* ws = ws_; MAKE_FRAME();
    LAS unsigned char* L = F.lds;
    const int lane = F.lane, wave = F.wave, tid = F.tid, fr = lane & 15, fq = lane >> 4;
    const bf16_t* proj = (const bf16_t*)(ws + WS_PROJ);
    const bf16_t* pb = proj + (size_t)b * SEQ * NPROJ;
    const bf16_t* kvb = (const bf16_t*)(ws + WS_KVI) + (size_t)b * SEQ * KV_LD;
    bf16_t* mix = (bf16_t*)(ws + WS_MIX);
    {
        const u32x4* kp = (const u32x4*)(kvb + (size_t)(tid >> 2) * KV_LD + KV_IK + 16 * (tid & 3));
        const u32x4 k0 = kp[0], k1 = kp[1]; const unsigned kw[8] = {k0.x, k0.y, k0.z, k0.w, k1.x, k1.y, k1.z, k1.w};
        float sq = 0.f;
#pragma unroll
        for (int j = 0; j < 8; ++j) { const float a = bflo(kw[j]), c = bfhi(kw[j]); sq += a * a + c * c; }
        sq = wave_sum(sq);
        if (lane == 0) ((LAS float*)(L + DS_RED))[wave] = sq;
        const float* lut = (const float*)(ws + WS_TAB + TB_LUT);
        for (int i = tid; i < 1024; i += NWAVES * 64) ((LAS float*)(L + DS_LUT))[i] = 8.0f * lut[i];
        for (int i = tid; i < 16384; i += NWAVES * 64) ((LAS unsigned*)(L + DS_HIST))[i] = 0u;
        for (int i = tid; i < 8192; i += NWAVES * 64) ((LAS unsigned*)(L + DS_BITS))[i] = 0u;
    }
    __syncthreads();
    float krms;
    { const LAS float* rp = (const LAS float*)(L + DS_RED); krms = sqrtf((((rp[0] + rp[1]) + (rp[2] + rp[3])) + ((rp[4] + rp[5]) + (rp[6] + rp[7]))) * (1.0f / 8192.0f)); }
    float qinv;
    {
        const int qg = wave & 3; const int tq = 64 * qb + 16 * qg + fr;
        DsaQ Q; dsa_build_q(Q, pb, kvb, (size_t)tq, fq, krms);
        dsa_pass<1>(L, kvb + KV_IK, qb, wave, lane, Q, tq, 0, sc);
        qinv = Q.inv;
    }
    for (int qi = 0; qi < 8; ++qi) {
        const int q = 8 * wave + qi, t = 64 * qb + q, n = t + 1;
        int bst = -1, rr = 0, nst = 0;
        if (n > TOPK) {
            const LAS unsigned* hp = (const LAS unsigned*)(L + DS_HIST) + q * 256;
            int c[4]; int s4 = 0;
#pragma unroll
            for (int j = 0; j < 4; ++j) { c[j] = (int)hp[4 * lane + j]; s4 += c[j]; }
            int x = s4;
#pragma unroll
            for (int o = 1; o < 64; o <<= 1) { const int y = bperm_i(x, lane + o); if (lane + o < 64) x += y; }
            int cum = x - s4; int fb = -1, fc = 0, fn = 0;
#pragma unroll
            for (int j = 3; j >= 0; --j) { if (cum < TOPK && TOPK <= cum + c[j]) { fb = 4 * lane + j; fc = cum; fn = c[j]; } cum += c[j]; }
            const unsigned long long m = __ballot(fb >= 0);
            const int src = m ? (int)__builtin_ctzll(m) : 0;
            bst = __builtin_amdgcn_readlane(fb, src); rr = TOPK - __builtin_amdgcn_readlane(fc, src); nst = __builtin_amdgcn_readlane(fn, src);
        }
        if (lane == 0) { LAS int* tp = (LAS int*)(L + DS_THR) + 4 * q; tp[0] = bst; tp[1] = rr; tp[2] = nst; tp[3] = 0; }
    }
    __syncthreads();
    for (int i = tid; i < 8192; i += NWAVES * 64) ((LAS unsigned*)(L + DS_TIE))[i] = 0u;
    __syncthreads();
    {
        const int qg = wave & 3; const int tq = 64 * qb + 16 * qg + fr;
        const int bstar = ((const LAS int*)(L + DS_THR))[4 * (16 * qg + fr)];
        const float bstarf = (float)(bstar - 128);
        const float shi = dsa_thr_score(qinv, bstarf, true), slo = dsa_thr_score(qinv, bstarf, false);
        dsa_pass2s(L, sc, qb, wave, lane, tq, shi, slo);
    }
    LAS unsigned char* WM = L + DS_WMISC + wave * 1024;
    LAS unsigned short* LIST = (LAS unsigned short*)(WM + DW_LIST);
    LAS unsigned* SCR = (LAS unsigned*)(WM + DW_SCR);
#pragma unroll 1
    for (int qi = (half == 1 ? 4 : 0); qi < (half == 0 ? 4 : 8); ++qi) {
        const int q = 8 * wave + qi, qcol = q & 15;
        const LAS int* tp = (const LAS int*)(L + DS_THR) + 4 * q;
        const int bst = tp[0], rr = tp[1], nst = tp[2];
        if (rr > 0 && rr < nst && bst != 128 && nst <= 64) {
            const LAS unsigned* TW = (const LAS unsigned*)(L + DS_TIE) + q * 128;
            const unsigned tw0 = TW[2 * lane], tw1 = TW[2 * lane + 1];
            LAS unsigned short* IDXR = (LAS unsigned short*)(L + DS_CAND + q * 512 + 256);
            { int tot_; BITS_ENUM(tw0, tw1, lane, tot_, { if (pos < 64) IDXR[pos] = (unsigned short)key; }); (void)tot_; }
            asm volatile("s_waitcnt lgkmcnt(0)" ::: "memory");
            const int ky = lane < nst ? (int)IDXR[lane] : 0, sb = (ky >> 4) & 7;
            const unsigned* dp = (const unsigned*)(sc + (size_t)((((ky >> 7) * 8 + (sb & 1) * 4 + (q >> 4)) * 4 + (sb >> 1)) * 64 + ((ky >> 2) & 3) * 16 + qcol)) + ((ky >> 1) & 1);
            glds4(dp, (unsigned)__builtin_amdgcn_readfirstlane((int)(unsigned)(size_t)(L + DS_CAND + q * 512)));
        }
    }
    asm volatile("s_waitcnt vmcnt(0)" ::: "memory");
#pragma unroll 1
    for (int qi = (half == 1 ? 4 : 0); qi < (half == 0 ? 4 : 8); ++qi) {
        const int q = 8 * wave + qi, t = 64 * qb + q, n = t + 1, qcol = q & 15;
        const LAS int* tp = (const LAS int*)(L + DS_THR) + 4 * q;
        const int bst = tp[0], rr = tp[1], nst = tp[2];
        LAS unsigned* BW = (LAS unsigned*)(L + DS_BITS) + q * 128;
        const LAS unsigned* TW = (const LAS unsigned*)(L + DS_TIE) + q * 128;
        if (rr > 0) {
            const unsigned tw0 = TW[2 * lane], tw1 = TW[2 * lane + 1];
            const int ZBq = 128;
            if (rr >= nst) { BW[2 * lane] |= tw0; BW[2 * lane + 1] |= tw1; }
            else if (bst == ZBq) {
                int tot; BITS_ENUM(tw0, tw1, lane, tot, { if (pos < rr) __hip_atomic_fetch_or(BW + (key >> 5), 1u << (key & 31), __ATOMIC_RELAXED, __HIP_MEMORY_SCOPE_WORKGROUP); });
                (void)tot;
            } else {
                const int nb = (nst + 63) >> 6;
                unsigned k0 = 0u; int idx0 = 0;
#define TIE_BATCH(bt_, KOUT, IOUT) do { \
                    { int tot_; BITS_ENUM(tw0, tw1, lane, tot_, { const int pp_ = pos - 64 * (bt_); if (pp_ >= 0 && pp_ < 64) LIST[pp_] = (unsigned short)key; }); (void)tot_; } \
                    asm volatile("s_waitcnt lgkmcnt(0)" ::: "memory"); \
                    const int rem_ = nst - 64 * (bt_); const bool v_ = lane < rem_; IOUT = v_ ? (int)LIST[lane] : 0; \
                      \
                    const int ky_ = IOUT, sb_ = (ky_ >> 4) & 7; \
                    const unsigned short* sp_ = (const unsigned short*)(sc + (size_t)((((ky_ >> 7) * 8 + (sb_ & 1) * 4 + (q >> 4)) * 4 + (sb_ >> 1)) * 64 + ((ky_ >> 2) & 3) * 16 + qcol)) + (ky_ & 3); \
                    KOUT = v_ ? fkey(h16f((unsigned)*sp_)) : 0u; } while (0)
                const int tmode = nb == 1 ? 0 : (nst <= 512 ? 1 : 2);
                LAS u32x2* KE = (LAS u32x2*)(L + wave * 4096);
                if (tmode == 0) {
                    { const LAS unsigned* SCRW = (const LAS unsigned*)(L + DS_CAND + q * 512); const LAS unsigned short* IDXR = (const LAS unsigned short*)(L + DS_CAND + q * 512 + 256);
                      const bool v_ = lane < nst; idx0 = v_ ? (int)IDXR[lane] : 0; const unsigned dw_ = SCRW[lane];
                      const unsigned hb_ = (idx0 & 1) ? (dw_ >> 16) : (dw_ & 0xffffu);
                      k0 = v_ ? ((hb_ & 0x8000u) ? (~hb_ & 0xffffu) : (hb_ | 0x8000u)) : 0u; }
                    unsigned T = 0u;
                    for (int bit = 15; bit >= 0; --bit) { const unsigned cand = T | (1u << bit); if ((int)__builtin_popcountll(__ballot(k0 >= cand)) >= rr) T = cand; }
                    const int cgt = (int)__builtin_popcountll(__ballot(k0 > T));
                    const unsigned long long be = __ballot(k0 == T && lane < nst);
                    const unsigned long long lt = (lane == 0) ? 0ull : (~0ull >> (64 - lane));
                    const bool take = (k0 > T) || (k0 == T && lane < nst && (int)__builtin_popcountll(be & lt) < rr - cgt);
                    if (take) __hip_atomic_fetch_or(BW + (idx0 >> 5), 1u << (idx0 & 31), __ATOMIC_RELAXED, __HIP_MEMORY_SCOPE_WORKGROUP);
                } else {
                if (tmode == 1) { for (int bt = 0; bt < nb; ++bt) { unsigned kk; int ii; TIE_BATCH(bt, kk, ii); if (lane < nst - 64 * bt) { u32x2 e; e.x = kk; e.y = (unsigned)ii; KE[64 * bt + lane] = e; } }
                    asm volatile("s_waitcnt lgkmcnt(0)" ::: "memory"); }
#define TIE_GET(bt_, KOUT, IOUT) do { if (tmode == 0) { KOUT = k0; IOUT = idx0; } else if (tmode == 1) { const bool vv_ = lane < nst - 64 * (bt_); const u32x2 e_ = KE[vv_ ? 64 * (bt_) + lane : 0]; KOUT = vv_ ? e_.x : 0u; IOUT = vv_ ? (int)e_.y : 0; } \
                    else TIE_BATCH(bt_, KOUT, IOUT); } while (0)
                unsigned T = 0u;
                for (int bit = 31; bit >= 0; --bit) {
                    const unsigned cand = T | (1u << bit); int cnt = 0;
                    for (int bt = 0; bt < nb; ++bt) { unsigned kk; int ii; TIE_GET(bt, kk, ii); (void)ii; cnt += __builtin_popcountll(__ballot(lane < nst - 64 * bt && kk >= cand)); }
                    if (cnt >= rr) T = cand;
                }
                int cgt = 0;
                for (int bt = 0; bt < nb; ++bt) { unsigned kk; int ii; TIE_GET(bt, kk, ii); (void)ii; cgt += __builtin_popcountll(__ballot(lane < nst - 64 * bt && kk > T)); }
                int eqleft = rr - cgt;
                const unsigned long long lt = (lane == 0) ? 0ull : (~0ull >> (64 - lane));
                for (int bt = 0; bt < nb; ++bt) {
                    unsigned kk; int ii; TIE_GET(bt, kk, ii);
                    const bool v = lane < nst - 64 * bt; const bool pg = v && kk > T, pe = v && kk == T;
                    const unsigned long long be = __ballot(pe);
                    int eqrank = (int)__builtin_popcountll(be & lt);
                    if (tmode == 0) { eqrank = 0; unsigned long long m_ = be;
                        while (m_) { const int j_ = (int)__builtin_ctzll(m_); m_ &= m_ - 1ull; const int ij_ = __builtin_amdgcn_readlane(ii, j_); eqrank += (pe && ij_ < ii) ? 1 : 0; } }
                    const bool take = pg || (pe && eqrank < eqleft);
                    if (take) __hip_atomic_fetch_or(BW + (ii >> 5), 1u << (ii & 31), __ATOMIC_RELAXED, __HIP_MEMORY_SCOPE_WORKGROUP);
                    eqleft -= (int)__builtin_popcountll(be); eqleft = eqleft < 0 ? 0 : eqleft;
                }
                }
#undef TIE_GET
#undef TIE_BATCH
            }
            asm volatile("s_waitcnt lgkmcnt(0)" ::: "memory");
        }
        int nsel;
        LAS unsigned short* LQ = (LAS unsigned short*)(L + DS_TIE) + q * 256;
        { const unsigned bw0 = BW[2 * lane], bw1 = BW[2 * lane + 1];
          asm volatile("s_waitcnt lgkmcnt(0)" ::: "memory");
          BITS_ENUM(bw0, bw1, lane, nsel, { if (pos < TOPK) LQ[pos] = (unsigned short)key; }); }
        nsel = nsel > TOPK ? TOPK : nsel;
        for (int i = nsel + lane; i < TOPK; i += 64) LQ[i] = 0;
        asm volatile("s_waitcnt lgkmcnt(0)" ::: "memory");
    }
    {
        const int qlo = (half == 1 ? 4 : 0), nq = (half == 2 ? 8 : 4), nstep = 4 * nq;
        LAS unsigned char* vb = L + wave * 4096;
        bf16x8 kA[4][2], kB[4][2]; u32x4 vA[2][4], vB[2][4]; bf16x8 qfA[2], qfB[2];
        const bf16x8 zf = {0, 0, 0, 0, 0, 0, 0, 0};
        float m_run = -1e30f, l_run = 0.f; f32x4 oacc[4];
        const float bfar = ((const LAS float*)(L + DS_LUT))[127 * 8 + (fr & 7)];
#pragma unroll
        for (int dt = 0; dt < 4; ++dt) oacc[dt] = (f32x4){0.f, 0.f, 0.f, 0.f};
#define AT_LOAD(kX, vX, s_) do { const int q_ = 8 * wave + qlo + ((s_) >> 2), g_ = (s_) & 3; const LAS unsigned short* LQ_ = (const LAS unsigned short*)(L + DS_TIE) + q_ * 256 + 64 * g_; \
            _Pragma("unroll") for (int tt = 0; tt < 4; ++tt) { const int sk_ = LQ_[16 * tt + fr]; const bf16_t* kr_ = kvb + (size_t)sk_ * KV_LD + KV_DK + 8 * fq; kX[tt][0] = *(const bf16x8*)kr_; kX[tt][1] = *(const bf16x8*)(kr_ + 32); } \
            _Pragma("unroll") for (int st = 0; st < 2; ++st) _Pragma("unroll") for (int i4 = 0; i4 < 4; ++i4) { const int sv_ = LQ_[32 * st + 8 * i4 + (lane >> 3)]; vX[st][i4] = *(const u32x4*)(kvb + (size_t)sv_ * KV_LD + KV_DV + 8 * (lane & 7)); } } while (0)
#define AT_LOADQ(qfX, s_) do { const int q_ = 8 * wave + qlo + ((s_) >> 2); const bf16_t* qp_ = proj + ((size_t)b * SEQ + 64 * qb + q_) * NPROJ + PC_DQ + (fr & 7) * 64 + 8 * fq; \
            qfX[0] = fr < 8 ? *(const bf16x8*)qp_ : zf; qfX[1] = fr < 8 ? *(const bf16x8*)(qp_ + 32) : zf; } while (0)
#define AT_COMPUTE(kX, vX, qfX, s_) do { const int q_ = 8 * wave + qlo + ((s_) >> 2), g_ = (s_) & 3, t_ = 64 * qb + q_; const int nsel_ = (t_ + 1) > TOPK ? TOPK : (t_ + 1); \
            const LAS unsigned short* LQ_ = (const LAS unsigned short*)(L + DS_TIE) + q_ * 256 + 64 * g_; \
            if (g_ == 0) { m_run = -1e30f; l_run = 0.f; _Pragma("unroll") for (int dt = 0; dt < 4; ++dt) oacc[dt] = (f32x4){0.f, 0.f, 0.f, 0.f}; } \
            f32x4 lg_[4]; \
              \
            const int far_ = __builtin_amdgcn_readfirstlane((nsel_ == TOPK && t_ - (int)LQ_[63] >= 127) ? 1 : 0); \
            if (far_) { _Pragma("unroll") for (int tt = 0; tt < 4; ++tt) lg_[tt] = (f32x4){bfar, bfar, bfar, bfar}; } \
            else { _Pragma("unroll") for (int tt = 0; tt < 4; ++tt) { const u32x2 sv_ = *(const LAS u32x2*)(LQ_ + 16 * tt + 4 * fq); \
                const int s4_[4] = {(int)(sv_.x & 0xffffu), (int)(sv_.x >> 16), (int)(sv_.y & 0xffffu), (int)(sv_.y >> 16)}; f32x4 bz_; \
                _Pragma("unroll") for (int r = 0; r < 4; ++r) { int d_ = t_ - s4_[r]; d_ = d_ > 127 ? 127 : d_; \
                    bz_[r] = ((const LAS float*)(L + DS_LUT))[d_ * 8 + (fr & 7)]; } \
                if (nsel_ < TOPK) { _Pragma("unroll") for (int r = 0; r < 4; ++r) bz_[r] = (64 * g_ + 16 * tt + 4 * fq + r < nsel_) ? bz_[r] : -8e30f; }      \
                lg_[tt] = bz_; } } \
            _Pragma("unroll") for (int tt = 0; tt < 4; ++tt) { lg_[tt] = __builtin_amdgcn_mfma_f32_16x16x32_bf16(kX[tt][0], qfX[0], lg_[tt], 0, 0, 0); lg_[tt] = __builtin_amdgcn_mfma_f32_16x16x32_bf16(kX[tt][1], qfX[1], lg_[tt], 0, 0, 0); } \
            float gm_ = fmaxf(fmaxf(fmaxf(lg_[0][0], lg_[0][1]), fmaxf(lg_[0][2], lg_[0][3])), fmaxf(fmaxf(lg_[1][0], lg_[1][1]), fmaxf(lg_[1][2], lg_[1][3]))); \
            gm_ = fmaxf(gm_, fmaxf(fmaxf(fmaxf(lg_[2][0], lg_[2][1]), fmaxf(lg_[2][2], lg_[2][3])), fmaxf(fmaxf(lg_[3][0], lg_[3][1]), fmaxf(lg_[3][2], lg_[3][3])))); \
              \
              \
              \
            gm_ = xq_max(gm_); float ps_ = 0.f; \
            if (__builtin_amdgcn_ballot_w64((gm_ - m_run) * 0.18033688f > 6.0f) != 0ull) { const float mn_ = fmaxf(m_run, gm_); const float al_ = __builtin_amdgcn_exp2f((m_run - mn_) * 0.18033688f); m_run = mn_; l_run *= al_; \
                _Pragma("unroll") for (int dt = 0; dt < 4; ++dt) oacc[dt] = oacc[dt] * al_; } \
            const float nmc_ = -m_run * 0.18033688f; \
            _Pragma("unroll") for (int tt = 0; tt < 4; ++tt) _Pragma("unroll") for (int r = 0; r < 4; ++r) { const float e_ = __builtin_amdgcn_exp2f(__builtin_fmaf(lg_[tt][r], 0.18033688f, nmc_)); lg_[tt][r] = e_; ps_ += e_; } \
            ps_ = xq_sum(ps_); l_run += ps_; \
            _Pragma("unroll") for (int st = 0; st < 2; ++st) { \
                _Pragma("unroll") for (int i4 = 0; i4 < 4; ++i4) { const int row_ = 8 * i4 + (lane >> 3); *(LAS u32x4*)(vb + swzB(row_, 16 * (lane & 7))) = vX[st][i4]; } \
                u32x4 pw_; pw_.x = pg8::cvt_pk_bf16(lg_[2 * st][0], lg_[2 * st][1]); pw_.y = pg8::cvt_pk_bf16(lg_[2 * st][2], lg_[2 * st][3]); pw_.z = pg8::cvt_pk_bf16(lg_[2 * st + 1][0], lg_[2 * st + 1][1]); pw_.w = pg8::cvt_pk_bf16(lg_[2 * st + 1][2], lg_[2 * st + 1][3]); \
                const bf16x8 pbv_ = __builtin_bit_cast(bf16x8, pw_); \
                _Pragma("unroll") for (int dt = 0; dt < 4; ++dt) { \
                    const s16x4 v0_ = tr_rd(vb + swzB(4 * fq + (fr >> 2), 32 * dt + 8 * (fr & 3))), v1_ = tr_rd(vb + swzB(16 + 4 * fq + (fr >> 2), 32 * dt + 8 * (fr & 3))); \
                    const bf16x8 va_ = __builtin_shufflevector(v0_, v1_, 0, 1, 2, 3, 4, 5, 6, 7); \
                    oacc[dt] = __builtin_amdgcn_mfma_f32_16x16x32_bf16(va_, pbv_, oacc[dt], 0, 0, 0); } \
                asm volatile("" ::: "memory"); } \
            if (g_ == 3) { const float ri_ = 1.0f / l_run; const size_t tok_ = (size_t)b * SEQ + t_; \
                if (fr < 8) { _Pragma("unroll") for (int dt = 0; dt < 4; ++dt) { u32x2 ow_; ow_.x = pg8::cvt_pk_bf16(oacc[dt][0] * ri_, oacc[dt][1] * ri_); ow_.y = pg8::cvt_pk_bf16(oacc[dt][2] * ri_, oacc[dt][3] * ri_); \
                    *(u32x2*)(mix + tok_ * 1024 + 256 + fr * 64 + 16 * dt + 4 * fq) = ow_; } } } } while (0)
#define SB() __builtin_amdgcn_sched_barrier(0)
        AT_LOADQ(qfA, 0); AT_LOAD(kA, vA, 0); SB();
#pragma unroll 1
        for (int s2 = 0; s2 < nstep; s2 += 2) {
            AT_LOAD(kB, vB, s2 + 1); SB();
            AT_COMPUTE(kA, vA, qfA, s2); SB();
            if (s2 + 2 < nstep) { if (((s2 + 2) & 3) == 0) AT_LOADQ(qfB, s2 + 2); AT_LOAD(kA, vA, s2 + 2); } SB();
            AT_COMPUTE(kB, vB, qfA, s2 + 1); SB();
            if (((s2 + 2) & 3) == 0) { qfA[0] = qfB[0]; qfA[1] = qfB[1]; }
        }
#undef AT_LOAD
#undef AT_LOADQ
#undef AT_COMPUTE
    }
    asm volatile("s_waitcnt lgkmcnt(0)" ::: "memory");
    __syncthreads();
}

__global__ void __launch_bounds__(NWAVES * 64, 2) trunk_fwd(Args args) {
    extern __shared__ __attribute__((aligned(16))) unsigned char lds_raw[];
    unsigned* ctl = (unsigned*)(args.ws + WS_CTL);
    const int wave_id = __builtin_amdgcn_readfirstlane(threadIdx.x >> 6);
    volatile LAS unsigned* MISC = (volatile LAS unsigned*)((LAS unsigned char*)lds_raw + MISC_OFF);
    if (wave_id == 0) MISC[lane_id()] = 0u;
    __syncthreads();
    XcdBarrier bar = xcd_barrier_post(ctl + CW_BAR, MISC + 8, wave_id == 0 && lane_id() == 0);
#define GRID_BAR() do { XcdBarrier bb_ = bar; asm volatile("" : "+s"(bb_.bar)); asm volatile("" : "+s"(bb_.x)); xcd_barrier(bb_, wave_id == 0 && lane_id() == 0); } while (0)
#define LOCAL_BAR() do { unsigned* bp_ = bar.bar; asm volatile("" : "+s"(bp_)); group_barrier(bp_, MISC[10], wave_id == 0 && lane_id() == 0); } while (0)
#define PHASE_PTRS() size_t z_ = 0; asm volatile("" : "+s"(z_)); unsigned char* ws = args.ws + z_;     \
    bf16_t* WIN = (bf16_t*)(ws + WS_WIN); bf16_t* WOUT = (bf16_t*)(ws + WS_WOUT); bf16_t* WFFI = (bf16_t*)(ws + WS_WFFI); bf16_t* WFFO = (bf16_t*)(ws + WS_WFFO); \
    bf16_t* XB = (bf16_t*)(ws + WS_XB); float* SS = (float*)(ws + WS_SS); bf16_t* PROJ = (bf16_t*)(ws + WS_PROJ); bf16_t* MIX = (bf16_t*)(ws + WS_MIX); bf16_t* HID = (bf16_t*)(ws + WS_HID); \
    bf16_t* YG = (bf16_t*)(ws + WS_YG); float* tabf = (float*)(ws + WS_TAB); \
    (void)WIN; (void)WOUT; (void)WFFI; (void)WFFO; (void)XB; (void)SS; (void)PROJ; (void)MIX; (void)HID; (void)YG; (void)tabf; MAKE_FRAME();
#define LAYER_IDX() int l = l_; asm volatile("" : "+s"(l));

    {
        PHASE_PTRS();
        if (wave_id == 0 && lane_id() == 0 && xb_xcc_id() != (blockIdx.x & 7u)) (void)xb_add(ctl + CW_BAR + XB_MISM, 1u);
        LAS float* scr = (LAS float*)(F.lds + F.wave * 16384);
        const bool qfirst_ = (((int)blockIdx.x >> 3) & 1) == 0;
#pragma unroll 1
        for (int step_ = 0; step_ < 2; ++step_) {
        if ((step_ == 0) == qfirst_) {
        {   constexpr int U_IN = NPROJ / 32, U_FFI = 2 * D_FF / 32;
            for (int u = (int)blockIdx.x; u < U_IN + U_FFI; u += F.G) {
                if (u < U_IN) { const int l = 0, nb = u;
                    quant_cols_unit<1>(args.in[1] + (size_t)l * D_MODEL * IN_W, IN_W, args.in[3] + l * D_MODEL, ws + WS_WIN8 + (size_t)l * NPROJ * D_MODEL, (float*)(ws + WS_SWIN) + (size_t)l * NPROJ, 32 * nb, F.lds, F.wave, F.lane); }
                else { const int l = 0, nb = u - U_IN;
                    quant_cols_unit<2>(args.in[17] + (size_t)l * D_MODEL * 2 * D_FF, 2 * D_FF, args.in[16] + l * D_MODEL, ws + WS_WFFI8 + (size_t)l * 2 * D_FF * D_MODEL, (float*)(ws + WS_SWF) + (size_t)l * 2 * D_FF, 32 * nb, F.lds, F.wave, F.lane); }
            }
            __syncthreads(); }
        } else {
        constexpr int I_OUT = 16 * 32, I_FFO = (D_FF / 64) * 32, I_L = I_OUT + I_FFO;
        for (int it = F.gw; it < I_L; it += F.NGW) {
            const int l = 0; int r = it;
            if (r < I_OUT) { transpose_item<0>(args.in[2] + (size_t)l * 1024 * 1024, 1024, 1024, 1024, nullptr, WOUT + (size_t)l * 1024 * 1024, scr, r, F.lane); continue; } r -= I_OUT;
            transpose_item<0, true>(args.in[18] + (size_t)l * D_FF * D_MODEL, D_FF, D_MODEL, D_MODEL, nullptr, (bf16_t*)((unsigned char*)WFFO + (size_t)l * D_MODEL * D_FF), scr, r, F.lane);
        }
        for (int it = F.gw; it < DEPTH * 32; it += F.NGW) { const int l = it >> 5;
            transpose_item<0>(args.in[12] + (size_t)l * 65536, 256, 256, 256, nullptr, (bf16_t*)(ws + WS_GLUT) + (size_t)l * 65536, scr, it & 31, F.lane); }
        for (int m0 = 4 * F.gw; m0 < MTOK; m0 += 4 * F.NGW) {
            f32x4 v[4][4];
#pragma unroll
            for (int r = 0; r < 4; ++r) { const f32x4* xr = (const f32x4*)(args.in[0] + (size_t)(m0 + r) * D_MODEL) + F.lane;
#pragma unroll
                for (int j = 0; j < 4; ++j) v[r][j] = xr[64 * j]; }
            __builtin_amdgcn_sched_barrier(0);
#pragma unroll
            for (int r = 0; r < 4; ++r) { const int m = m0 + r; float s = 0.f, mx = 0.f;
#pragma unroll
                for (int j = 0; j < 4; ++j) { s += (v[r][j][0] * v[r][j][0] + v[r][j][1] * v[r][j][1]) + (v[r][j][2] * v[r][j][2] + v[r][j][3] * v[r][j][3]);
                    mx = fmaxf(fmaxf(mx, fmaxf(fabsf(v[r][j][0]), fabsf(v[r][j][1]))), fmaxf(fabsf(v[r][j][2]), fabsf(v[r][j][3]))); }
                s = wave_sum(s); mx = wave_max(mx); const float inv = mx > 0.f ? 127.0f / mx : 0.f;
                u32x2* o8 = (u32x2*)(XB + (size_t)m * D_MODEL) + F.lane; unsigned* q4 = (unsigned*)(ws + WS_XQ8 + (size_t)m * D_MODEL) + F.lane;
#pragma unroll
                for (int j = 0; j < 4; ++j) { u32x2 w; w.x = pk2(v[r][j][0], v[r][j][1]); w.y = pk2(v[r][j][2], v[r][j][3]); o8[64 * j] = w;
                    const int q0 = (int)__builtin_rintf(v[r][j][0] * inv), q1 = (int)__builtin_rintf(v[r][j][1] * inv), q2 = (int)__builtin_rintf(v[r][j][2] * inv), q3 = (int)__builtin_rintf(v[r][j][3] * inv);
                    q4[64 * j] = (unsigned)(q0 & 255) | ((unsigned)(q1 & 255) << 8) | ((unsigned)(q2 & 255) << 16) | ((unsigned)(q3 & 255) << 24); }
                if (F.lane < 16) SS[(size_t)m * 16 + F.lane] = (F.lane == 0) ? s : 0.f;
                if (F.lane == 0) ((float*)(ws + WS_SA))[m] = mx * (1.0f / 127.0f); }
        }
        }
        }
        const int gt = blockIdx.x * (NWAVES * 64) + F.tid, NT = F.G * NWAVES * 64;
        for (int i = gt; i < SEQ * 32; i += NT) { const int pos = i >> 5, fi = i & 31;
            const float inv = powf(10000.0f, -(float)fi / 32.0f); const float ang = (float)pos * inv;
            tabf[TB_ROPE / 4 + (size_t)i * 2] = cosf(ang); tabf[TB_ROPE / 4 + (size_t)i * 2 + 1] = sinf(ang); }
        for (int i = gt; i < 128 * 8; i += NT) { const int dist = i >> 3, hh = i & 7;
            int bk; if (dist < 16) bk = dist; else { bk = 16 + (int)(logf((float)dist / 16.0f) / 2.0794415416798357f * 16.0f); bk = bk > 31 ? 31 : bk; }
            tabf[TB_LUT / 4 + i] = args.in[14][bk * 8 + hh]; }
#define S5_DISC(i__) const int l = (i__) / (S5_G * S5_N), g = ((i__) / S5_N) % S5_G, n = (i__) % S5_N; \
            const float ar = args.in[4][(i__)], ai = args.in[5][(i__)]; const float dt = expf(args.in[6][l * S5_G + g]); \
            const float mag = expf(ar * dt), ang = ai * dt; const float abr = mag * cosf(ang), abi = mag * sinf(ang); \
            const float den = ar * ar + ai * ai, nr = abr - 1.0f, ni = abi; \
            const float cr = (nr * ar + ni * ai) / den, ci = (ni * ar - nr * ai) / den; (void)l; (void)g; (void)n; (void)cr; (void)ci;
        if (F.tid < 16) for (int i = (int)blockIdx.x * 16 + F.tid; i < DEPTH * S5_G * S5_N; i += F.G * 16) { S5_DISC(i)
            tabf[TB_S5AB / 4 + (size_t)i * 2] = abr; tabf[TB_S5AB / 4 + (size_t)i * 2 + 1] = abi;
            float pr = 1.f, pi = 0.f; float* pw = tabf + TB_POW / 4 + (size_t)i * 130;
            for (int d = 0; d <= 64; ++d) { pw[2 * d] = pr; pw[2 * d + 1] = pi; const float nr2 = pr * abr - pi * abi, ni2 = pr * abi + pi * abr; pr = nr2; pi = ni2; } }
        for (int j = gt; j < DEPTH * S5_G * S5_N * 16; j += NT) { const int i = j >> 4, q = j & 15; S5_DISC(i)
            const float br = args.in[7][(size_t)i * 16 + q], bi = args.in[8][(size_t)i * 16 + q];
            tabf[TB_S5BB / 4 + (size_t)i * 32 + 2 * q] = cr * br - ci * bi; tabf[TB_S5BB / 4 + (size_t)i * 32 + 2 * q + 1] = cr * bi + ci * br;
            const size_t cidx = ((size_t)(l * S5_G + g) * S5_P + q) * S5_N + n;
            tabf[TB_S5C / 4 + (size_t)i * 32 + 2 * q] = args.in[9][cidx]; tabf[TB_S5C / 4 + (size_t)i * 32 + 2 * q + 1] = args.in[10][cidx]; }
        {
            LAS float* pl = (LAS float*)F.lds;
            for (int u = (int)blockIdx.x; u < DEPTH * S5_G * 4; u += F.G) {
                const int lg = u >> 2, dq = u & 3;
                __syncthreads();
                for (int i = F.tid; i < 2048; i += NWAVES * 64) { const int nn = i >> 5, r = i & 31, qq = r >> 1, cc = r & 1, mi = lg * S5_N + nn; S5_DISC(mi)
                    float pr = 1.f, pi = 0.f; const int dpow = 16 * dq + qq;
                    for (int d = 0; d < dpow; ++d) { const float nr2 = pr * abr - pi * abi, ni2 = pr * abi + pi * abr; pr = nr2; pi = ni2; }
                    pl[i] = cc ? pi : pr;
                    const size_t cidx = ((size_t)(l * S5_G + g) * S5_P + qq) * S5_N + n;
                    pl[2048 + i] = cc ? args.in[10][cidx] : args.in[9][cidx];
                    const float br = args.in[7][(size_t)mi * 16 + qq], bi = args.in[8][(size_t)mi * 16 + qq];
                    pl[4096 + i] = cc ? (cr * bi + ci * br) : (cr * br - ci * bi); }
                __syncthreads();
                const int pq = F.tid & 255, p = pq >> 4, q = pq & 15, dh = F.wave >> 2;
                float acc[8];
#pragma unroll
                for (int d = 0; d < 8; ++d) acc[d] = 0.f;
#pragma unroll
                for (int n0 = 0; n0 < 64; n0 += 16) {
                    float wr[16], wi[16];
#pragma unroll
                    for (int k = 0; k < 16; ++k) { const int n = n0 + k; const float cr = pl[2048 + n * 32 + 2 * p], ci = pl[2048 + n * 32 + 2 * p + 1], br = pl[4096 + n * 32 + 2 * q], bi = pl[4096 + n * 32 + 2 * q + 1];
                        wr[k] = cr * br - ci * bi; wi[k] = cr * bi + ci * br; }
#pragma unroll
                    for (int d = 0; d < 8; ++d) { const int dd = 8 * dh + d; float s0 = 0.f, s1 = 0.f;
#pragma unroll
                        for (int k = 0; k < 16; k += 2) { const int n = n0 + k; const float pr0 = pl[n * 32 + 2 * dd], pi0 = pl[n * 32 + 2 * dd + 1], pr1 = pl[n * 32 + 32 + 2 * dd], pi1 = pl[n * 32 + 32 + 2 * dd + 1];
                            s0 += wr[k] * pr0 - wi[k] * pi0; s1 += wr[k + 1] * pr1 - wi[k + 1] * pi1; }
                        acc[d] += s0 + s1; }
                }
#pragma unroll
                for (int d = 0; d < 8; ++d) tabf[TB_KC / 4 + ((size_t)(lg * 64 + 16 * dq + 8 * dh + d)) * 256 + pq] = acc[d];
            }
        __syncthreads(); }
#undef S5_DISC
    }
    GRID_BAR();
    if (wave_id == 0 && lane_id() == 0) MISC[10] = xb_ld(ctl + CW_BAR + XB_MISM) | (gridDim.x != 256u ? 1u : 0u);
#define RESID_QUANT4(epoch__) do { __syncthreads(); \
        size_t zq_ = 0; asm volatile("" : "+s"(zq_)); unsigned char* wsq_ = args.ws + zq_; const int ln_ = lane_id();      \
        const bf16_t* XBq_ = (const bf16_t*)(wsq_ + WS_XB); LAS unsigned char* ldq_ = (LAS unsigned char*)lds_raw; const LAS unsigned* rmq_ = (const LAS unsigned*)(ldq_ + RING_BYTES); \
        unsigned* G_ = (unsigned*)wsq_ + CW_GRAN; LAS float* rsc_ = (LAS float*)(ldq_ + RING_BYTES + 2048); \
        pg8::StaticOrder Sq_; Sq_.init(MTOK, D_MODEL, 256, (int)blockIdx.x); \
        { pg8::Unit uq_; Sq_.next(wave_id >> 2, uq_); const int r_ = (wave_id & 3) * 64 + ln_; const unsigned own_ = rmq_[(wave_id >> 2) * 256 + r_] & 0xffff0000u; \
            __hip_atomic_store(G_ + ((size_t)(uq_.pm * 4 + uq_.pn) * 256 + r_), own_ | (unsigned)(epoch__), __ATOMIC_RELAXED, __HIP_MEMORY_SCOPE_AGENT); \
            unsigned mxb_ = own_, v1_, v2_, v3_, sp_ = 0u;            \
            for (;;) { v1_ = __hip_atomic_load(G_ + ((size_t)(uq_.pm * 4 + ((uq_.pn + 1) & 3)) * 256 + r_), __ATOMIC_RELAXED, __HIP_MEMORY_SCOPE_AGENT); \
                v2_ = __hip_atomic_load(G_ + ((size_t)(uq_.pm * 4 + ((uq_.pn + 2) & 3)) * 256 + r_), __ATOMIC_RELAXED, __HIP_MEMORY_SCOPE_AGENT); \
                v3_ = __hip_atomic_load(G_ + ((size_t)(uq_.pm * 4 + ((uq_.pn + 3) & 3)) * 256 + r_), __ATOMIC_RELAXED, __HIP_MEMORY_SCOPE_AGENT); \
                if ((v1_ & 0xffffu) == (unsigned)(epoch__) && (v2_ & 0xffffu) == (unsigned)(epoch__) && (v3_ & 0xffffu) == (unsigned)(epoch__)) break; \
                if (++sp_ > (1u << 22)) { atomicAdd((unsigned*)wsq_ + CW_BAR + XB_TMO, 1u); break; } __builtin_amdgcn_s_sleep(1); } \
            v1_ &= 0xffff0000u; v2_ &= 0xffff0000u; v3_ &= 0xffff0000u; mxb_ = v1_ > mxb_ ? v1_ : mxb_; mxb_ = v2_ > mxb_ ? v2_ : mxb_; mxb_ = v3_ > mxb_ ? v3_ : mxb_; \
            const float mx_ = __uint_as_float(mxb_); \
            rsc_[(wave_id >> 2) * 256 + r_] = mx_; if (uq_.pn == 0) ((float*)(wsq_ + WS_SA))[uq_.pm * 256 + r_] = mx_ * (1.0f / 127.0f); } \
        __syncthreads(); \
        for (int j_ = 0; j_ < 2; ++j_) { pg8::Unit uq_; Sq_.next(j_, uq_); \
            { u32x4 xw_[16]; const int r0_ = 8 * wave_id; const size_t eo_ = (size_t)(uq_.pm * 256 + r0_ + (ln_ >> 5)) * D_MODEL + 256 * uq_.pn + 8 * (ln_ & 31);        \
                _Pragma("unroll") for (int r = 0; r < 16; ++r) xw_[r] = *(const u32x4*)(XBq_ + eo_ + (size_t)(64 * (r >> 2) + 2 * (r & 3)) * D_MODEL); \
                __builtin_amdgcn_sched_barrier(0); \
                _Pragma("unroll") for (int r = 0; r < 16; ++r) { const float mxr_ = rsc_[j_ * 256 + r0_ + 64 * (r >> 2) + 2 * (r & 3) + (ln_ >> 5)]; const float inv_ = mxr_ > 0.f ? 127.0f / mxr_ : 0.f; const unsigned w4_[4] = {xw_[r].x, xw_[r].y, xw_[r].z, xw_[r].w}; u32x2 o_; \
                    { const int q0 = (int)__builtin_rintf(bflo(w4_[0]) * inv_), q1 = (int)__builtin_rintf(bfhi(w4_[0]) * inv_), q2 = (int)__builtin_rintf(bflo(w4_[1]) * inv_), q3 = (int)__builtin_rintf(bfhi(w4_[1]) * inv_); \
                      o_.x = (unsigned)(q0 & 255) | ((unsigned)(q1 & 255) << 8) | ((unsigned)(q2 & 255) << 16) | ((unsigned)(q3 & 255) << 24); } \
                    { const int q0 = (int)__builtin_rintf(bflo(w4_[2]) * inv_), q1 = (int)__builtin_rintf(bfhi(w4_[2]) * inv_), q2 = (int)__builtin_rintf(bflo(w4_[3]) * inv_), q3 = (int)__builtin_rintf(bfhi(w4_[3]) * inv_); \
                      o_.y = (unsigned)(q0 & 255) | ((unsigned)(q1 & 255) << 8) | ((unsigned)(q2 & 255) << 16) | ((unsigned)(q3 & 255) << 24); } \
                    *(u32x2*)(wsq_ + WS_XQ8 + eo_ + (size_t)(64 * (r >> 2) + 2 * (r & 3)) * D_MODEL) = o_; } } } \
    } while (0)
    for (int l_ = 0; l_ < DEPTH; ++l_) {
        {
            PHASE_PTRS(); LAYER_IDX();
            pg8::Gemm g{(const bf16_t*)(ws + WS_XQ8), (const bf16_t*)(ws + WS_WIN8 + (size_t)l * NPROJ * D_MODEL), D_MODEL / 2, D_MODEL / 2, D_MODEL / 2}; pg8::StaticOrder S; S.init(MTOK, NPROJ, F.G, (int)blockIdx.x);
            LAS float* rs_tab = (LAS float*)(F.lds + RING_BYTES);
            { const float* sa = (const float*)(ws + WS_SA); const int t_ = wave_id * 64 + lane_id(); pg8::Unit u_; int pmp_ = -1; float rv_ = 0.f;
              for (int i = 0; S.next(i, u_); ++i) if (wave_id < 4) { if (u_.pm != pmp_) { rv_ = pg8::row_rstd(SS, u_.pm * 256 + t_) * sa[u_.pm * 256 + t_]; pmp_ = u_.pm; } rs_tab[i * 256 + t_] = rv_; } }
            __syncthreads();
            pg8::EpiProjI E{PROJ, NPROJ, rs_tab, (bf16_t*)(ws + WS_S5U), (bf16_t*)(ws + WS_KVI), (const float*)(ws + WS_SWIN) + (size_t)l * NPROJ};
            pg8::gemm_phase<pg8::EpiProjI, pg8::StaticOrder, true, true, 0, 3>(F.lds, g, S, E, F.wave);
            {   constexpr int tail_ = (MTOK / 256) * (NPROJ / 256) % 256;
                static_assert(tail_ > 0 && tail_ < 256, "");
                size_t ze_ = 0; asm volatile("" : "+s"(ze_)); Frame Fe = F; Fe.ws = args.ws + ze_;
                if ((int)blockIdx.x >= tail_) s5_expand(Fe, args, l, (int)blockIdx.x - tail_, 256 - tail_); }
        }
        GRID_BAR();
        {
            PHASE_PTRS(); LAYER_IDX();
            unsigned* wkb = ctl + CW_WORK + 64 * 8 * l;
            { unsigned c_ = blockIdx.x; asm volatile("" : "+s"(c_));
              if (wave_id == 0 && lane_id() == 0) { MISC[17] = 0u; MISC[16] = (c_ & 7u) * 256u + (c_ >> 3); MISC[18] = 1u; } }
            for (;;) {
                __syncthreads();
                if (wave_id == 0 && lane_id() == 0) {
                    if (MISC[18]) MISC[18] = 0u;
                    else {
                    unsigned it = 0xffffffffu; const int myq = (int)(xb_xcc_id() & 7u); int qoff = (int)MISC[17]; const unsigned qn_ = l + 1 < DEPTH ? 88u + 31u : 88u;
                    for (; qoff < 8; ++qoff) { const int q = (myq + qoff) & 7; const unsigned i = 32u + __hip_atomic_fetch_add(wkb + 64 * q, 1u, __ATOMIC_RELAXED, __HIP_MEMORY_SCOPE_AGENT); if (i < qn_) { it = (unsigned)q * 256u + i; break; } }
                    MISC[16] = it; MISC[17] = (unsigned)qoff; }
                }
                __syncthreads();
                const unsigned it = (unsigned)__builtin_amdgcn_readfirstlane((int)MISC[16]);
                if (it == 0xffffffffu) break;
                const int q = (int)(it >> 8), i = (int)(it & 255u);
                if (i >= 88) {
                    const int uq = q * 31 + (i - 88), ln_ = l + 1; constexpr int U_IN = NPROJ / 32;
                    if (uq < U_IN) quant_cols_unit<1>(args.in[1] + (size_t)ln_ * D_MODEL * IN_W, IN_W, args.in[3] + ln_ * D_MODEL, ws + WS_WIN8 + (size_t)ln_ * NPROJ * D_MODEL, (float*)(ws + WS_SWIN) + (size_t)ln_ * NPROJ, 32 * uq, (LAS unsigned char*)lds_raw, wave_id, lane_id());
                    else quant_cols_unit<2>(args.in[17] + (size_t)ln_ * D_MODEL * 2 * D_FF, 2 * D_FF, args.in[16] + ln_ * D_MODEL, ws + WS_WFFI8 + (size_t)ln_ * 2 * D_FF * D_MODEL, (float*)(ws + WS_SWF) + (size_t)ln_ * 2 * D_FF, 32 * (uq - U_IN), (LAS unsigned char*)lds_raw, wave_id, lane_id());
                    __syncthreads(); }
                else if (i >= 4 && i < 8) ret_unit(ws, wave_id, args.in[15], l, q, i - 4);
                else if (i < 4) { const int u = q * 4 + i; s5_unit(ws, wave_id, l, u >> 1, u & 1); }
                else { u32x2* sc = (u32x2*)((unsigned char*)args.out + z_) + (size_t)blockIdx.x * 65536;
                    if (i < 56) dsa_qblock(ws, wave_id, q, 63 - (i - 8), 2, sc);
                    else dsa_qblock(ws, wave_id, q, 15 - ((i - 56) >> 1), (i - 56) & 1, sc); }
            }
        }
        GRID_BAR();
        {
            PHASE_PTRS(); LAYER_IDX();
            pg8::Gemm g{(const bf16_t*)YG, (const bf16_t*)(ws + WS_GLUT) + (size_t)l * 65536, 256, 256, 256}; pg8::StaticOrder S; S.init(MTOK, 256, F.G, (int)blockIdx.x);
            pg8::EpiGLU E{(const bf16_t*)YG, MIX, args.in[13] + (size_t)l * 256};
            if ((int)blockIdx.x >= 128 && l + 1 < DEPTH) {
                size_t zt_ = 0; asm volatile("" : "+s"(zt_)); unsigned char* wst_ = args.ws + zt_; const int ln_ = lane_id(); LAS float* scr_ = (LAS float*)((LAS unsigned char*)lds_raw + wave_id * 16384);
                constexpr int I_OUT = 16 * 32, I_FFO = (D_FF / 64) * 32;
                for (int it = ((int)blockIdx.x - 128) * NWAVES + wave_id; it < I_OUT + I_FFO; it += 128 * NWAVES) {
                    if (it < I_OUT) transpose_item<0>(args.in[2] + (size_t)(l + 1) * 1024 * 1024, 1024, 1024, 1024, nullptr, (bf16_t*)(wst_ + WS_WOUT) + (size_t)(l + 1) * 1024 * 1024, scr_, it, ln_);
                    else transpose_item<0, true>(args.in[18] + (size_t)(l + 1) * D_FF * D_MODEL, D_FF, D_MODEL, D_MODEL, nullptr, (bf16_t*)(wst_ + WS_WFFO + (size_t)(l + 1) * D_MODEL * D_FF), scr_, it - I_OUT, ln_); }
            }
            pg8::gemm_phase<pg8::EpiGLU, pg8::StaticOrder, true, true>(F.lds, g, S, E, F.wave);
        }
        LOCAL_BAR();
        {
            PHASE_PTRS(); LAYER_IDX();
            { LAS unsigned* rmax = (LAS unsigned*)(F.lds + RING_BYTES); rmax[wave_id * 64 + lane_id()] = 0u; }
            __syncthreads();
            pg8::Gemm g{MIX, WOUT + (size_t)l * 1024 * 1024, 1024, 1024, 1024}; pg8::StaticOrder S; S.init(MTOK, D_MODEL, F.G, (int)blockIdx.x);
            pg8::EpiResidB E{XB, SS, 1.0f, RING_BYTES};
            pg8::gemm_phase<pg8::EpiResidB, pg8::StaticOrder, true, true>(F.lds, g, S, E, F.wave);
            RESID_QUANT4(1 + 2 * l);
        }
        LOCAL_BAR();
        {
            PHASE_PTRS(); LAYER_IDX();
            pg8::Gemm g{(const bf16_t*)(ws + WS_XQ8), (const bf16_t*)(ws + WS_WFFI8 + (size_t)l * 2 * D_FF * D_MODEL), D_MODEL / 2, D_MODEL / 2, D_MODEL / 2}; pg8::StaticOrder S; S.init(MTOK, 2 * D_FF, F.G, (int)blockIdx.x);
            LAS float* rs_tab = (LAS float*)(F.lds + RING_BYTES); LAS float* sw_l = rs_tab + 512;
            pg8::Unit u0_; S.next(0, u0_);
            { const int t_ = wave_id * 64 + lane_id();
              if (wave_id < 4) { const float* sa = (const float*)(ws + WS_SA); float rv_[2];
#pragma unroll
                  for (int po = 0; po < 2; ++po) { const int pm_ = u0_.pm + 8 * po; rv_[po] = pg8::row_rstd(SS, pm_ * 256 + t_) * sa[pm_ * 256 + t_]; }
                  rs_tab[t_] = rv_[0]; rs_tab[256 + t_] = rv_[1]; }
              else { const float* swg = (const float*)(ws + WS_SWF) + (size_t)l * 2 * D_FF + (t_ - 256); float sv_[11];
#pragma unroll
                  for (int i = 0; i < 11; ++i) { pg8::Unit u_; const bool ok_ = S.next(i, u_); sv_[i] = ok_ ? swg[u_.pn * 256] : 0.f; }
#pragma unroll
                  for (int i = 0; i < 11; ++i) sw_l[i * 256 + (t_ - 256)] = sv_[i]; } }
            __syncthreads();
            pg8::EpiSwiGLU8I E{(unsigned char*)HID, D_FF, rs_tab, sw_l, HID_BX, u0_.pm};
            pg8::gemm_phase<pg8::EpiSwiGLU8I, pg8::StaticOrder, true, true, 0, 3>(F.lds, g, S, E, F.wave);
        }
        LOCAL_BAR();
        {
            PHASE_PTRS(); LAYER_IDX();
            { LAS unsigned* rmax = (LAS unsigned*)(F.lds + RING_BYTES); rmax[wave_id * 64 + lane_id()] = 0u; }
            __syncthreads();
            pg8::Gemm g{HID, (const bf16_t*)((const unsigned char*)WFFO + (size_t)l * D_MODEL * D_FF), D_FF / 2, D_FF / 2, D_FF / 2, nullptr, HID_BX}; pg8::StaticOrder S; S.init(MTOK, D_MODEL, F.G, (int)blockIdx.x);
            pg8::EpiResidB E{XB, SS, 1.0f / (F8_WS * F8_HS), RING_BYTES};
            pg8::gemm_phase<pg8::EpiResidB, pg8::StaticOrder, true, true, 0, true>(F.lds, g, S, E, F.wave);
            if (l + 1 < DEPTH) RESID_QUANT4(2 + 2 * l);
        }
        LOCAL_BAR();
    }
    {
        PHASE_PTRS();
        const unsigned tmo = __hip_atomic_load(ctl + CW_BAR + XB_TMO, __ATOMIC_RELAXED, __HIP_MEMORY_SCOPE_AGENT);
        const float* gf = args.in[19];
        f32x4 gg[4];
#pragma unroll
        for (int j = 0; j < 4; ++j) gg[j] = ((const f32x4*)gf + F.lane)[64 * j];
        const int mb = SEQ * ((int)blockIdx.x & 7), lw = ((int)blockIdx.x >> 3) * NWAVES + F.wave;
        for (int m0 = mb + 4 * lw; m0 < mb + SEQ; m0 += 4 * (256 / 8) * NWAVES) {
            u32x2 xw[4][4]; float rs[4];
#pragma unroll
            for (int r = 0; r < 4; ++r) { const u32x2* xs = (const u32x2*)(XB + (size_t)(m0 + r) * D_MODEL) + F.lane;
#pragma unroll
                for (int j = 0; j < 4; ++j) xw[r][j] = xs[64 * j];
                rs[r] = pg8::row_rstd(SS, m0 + r); if (tmo) rs[r] = __builtin_nanf(""); }
            __builtin_amdgcn_sched_barrier(0);
#pragma unroll
            for (int r = 0; r < 4; ++r) { f32x4* xr = (f32x4*)(args.out + (size_t)(m0 + r) * D_MODEL) + F.lane;
#pragma unroll
                for (int j = 0; j < 4; ++j) { f32x4 v; v[0] = bflo(xw[r][j].x); v[1] = bfhi(xw[r][j].x); v[2] = bflo(xw[r][j].y); v[3] = bfhi(xw[r][j].y); xr[64 * j] = v * rs[r] * gg[j]; } }
        }
    }
}

extern "C" void kernel_launch(void* const* d_in, const int* in_sizes, int n_in, void* d_out, int out_size, void* d_ws, size_t ws_size, hipStream_t stream) {
    static int grid = 0;
    if (grid == 0) {
        if (n_in != 20 || out_size != MTOK * D_MODEL || ws_size < WS_END) { fprintf(stderr, "kernel_launch: unexpected problem (n_in %d, out %d, ws %zu)\n", n_in, out_size, ws_size); grid = -1; return; }
        int dev = 0, cus = 0, per_cu = 0;
        if (hipGetDevice(&dev) != hipSuccess || hipDeviceGetAttribute(&cus, hipDeviceAttributeMultiprocessorCount, dev) != hipSuccess) { grid = -1; return; }
        if (hipFuncSetAttribute((const void*)trunk_fwd, hipFuncAttributeMaxDynamicSharedMemorySize, LDS_BYTES) != hipSuccess) { fprintf(stderr, "kernel_launch: hipFuncSetAttribute failed\n"); grid = -1; return; }
        if (hipOccupancyMaxActiveBlocksPerMultiprocessor(&per_cu, (const void*)trunk_fwd, NWAVES * 64, LDS_BYTES) != hipSuccess || per_cu < 1) fprintf(stderr, "kernel_launch: occupancy query reports %d\n", per_cu);
        (void)hipGetLastError();
        if (cus < 256) { fprintf(stderr, "kernel_launch: %d compute units, 256 needed (the unit maps of the residual GEMMs and the group barriers are written for a grid of 256)\n", cus); grid = -1; return; }
        grid = 256;
    }
    if (grid < 0) return;
    if (hipMemsetAsync((char*)d_ws + WS_CTL, 0, CTL_ZERO_BYTES, stream) != hipSuccess) return;
    Args a{};
    for (int i = 0; i < 20; ++i) a.in[i] = (const float*)d_in[i];
    a.out = (float*)d_out; a.ws = (unsigned char*)d_ws;
    hipLaunchKernelGGL(trunk_fwd, dim3(grid), dim3(NWAVES * 64), LDS_BYTES, stream, a);
}
```
